# Optimizing an MI355X kernel written in HIP

```python
import jax, jax.numpy as jnp
from jax import lax
import numpy as np

D_MODEL = 1024
BATCH = 4
SEQ = 8192
DEPTH = 2
DEC_BATCH = 32
DEC_SEQ = 64
PAST_LEN = 1024

CHUNK = 64
GROUP_W = D_MODEL // 4
D_MIX = 4 * GROUP_W
N_SPLITS = 11
IN_COLS = N_SPLITS * GROUP_W
CONV_A_W = 3
CONV_B_W = 31
POOL_WINDOWS = (2, 4, 8, 16)
POOL_GROUPS = len(POOL_WINDOWS)
POOL_CH = GROUP_W // POOL_GROUPS
POOL_HIST = max(POOL_WINDOWS) - 1
N_MEM = 256
MEM_HEADS = 4
MEM_HEAD_DIM = GROUP_W // MEM_HEADS
EPS = 1e-6

kernel_name = 'hymba_conv_pool_memory_streaming_encoder'


def _rmsnorm(x, g):
    xf = x.astype(jnp.float32)
    return (xf * lax.rsqrt(jnp.mean(xf * xf, axis=-1, keepdims=True) + EPS) * g.astype(jnp.float32)).astype(x.dtype)


def _layernorm(x, g, b):
    xf = x.astype(jnp.float32)
    mu = jnp.mean(xf, axis=-1, keepdims=True)
    xc = xf - mu
    var = jnp.mean(xc * xc, axis=-1, keepdims=True)
    return (xc * lax.rsqrt(var + EPS) * g.astype(jnp.float32) + b.astype(jnp.float32)).astype(x.dtype)


def _dwconv(xpad, w):
    c = xpad.shape[-1]
    return lax.conv_general_dilated(xpad, w[:, None, :].astype(xpad.dtype), window_strides=(1,), padding='VALID',
                                    dimension_numbers=('NWC', 'WIO', 'NWC'), feature_group_count=c)


def _multiscale_trailing_mean(ppad, pos0):
    t = ppad.shape[1] - POOL_HIST
    cs = lax.cumsum(ppad.astype(jnp.float32), axis=1)
    cs = jnp.concatenate([jnp.zeros_like(cs[:, :1]), cs], axis=1)
    pos = pos0 + jnp.arange(t)
    outs = []
    for gi, w in enumerate(POOL_WINDOWS):
        sl = slice(gi * POOL_CH, (gi + 1) * POOL_CH)
        end = cs[:, POOL_HIST + 1:POOL_HIST + 1 + t, sl]
        start = cs[:, POOL_HIST + 1 - w:POOL_HIST + 1 - w + t, sl]
        cnt = jnp.minimum(w, pos + 1).astype(jnp.float32)[None, :, None]
        outs.append((end - start) / cnt)
    return jnp.concatenate(outs, axis=-1)


def _mem_kv(mem, g, w_k, w_v):
    b = mem.shape[0]
    mn = _rmsnorm(mem, g)
    k = jnp.einsum('bmd,de->bme', mn, w_k).reshape(b, N_MEM, MEM_HEADS, MEM_HEAD_DIM)
    v = jnp.einsum('bmd,de->bme', mn, w_v).reshape(b, N_MEM, MEM_HEADS, MEM_HEAD_DIM)
    return k, v


def _layer(x, hist_a, hist_b, hist_p, mem_k, mem_v, pos0, lp):
    norm_g, w_in, conv_a_w, conv_b_w, conv_b_bias, ln_b_g, ln_b_b, pool_w, pool_bias, pool_scale, w_out = lp
    b, t, _ = x.shape
    h = _rmsnorm(x, norm_g)
    u = jnp.einsum('btd,de->bte', h, w_in)
    a_b, a_c, a_x, a_g, b_v, b_a, b_g, c_u, c_g, x_q, x_g = jnp.split(u, N_SPLITS, axis=-1)

    v = a_c * a_x
    vpad = jnp.concatenate([hist_a, v], axis=1)
    y_a = a_b * _dwconv(vpad, conv_a_w) * jax.nn.silu(a_g)
    new_a = vpad[:, -(CONV_A_W - 1):]

    glu = b_v * jax.nn.sigmoid(b_a)
    gpad = jnp.concatenate([hist_b, glu], axis=1)
    z = _dwconv(gpad, conv_b_w) + conv_b_bias
    z = _layernorm(z, ln_b_g, ln_b_b)
    y_b = jax.nn.silu(z) * jax.nn.silu(b_g)
    new_b = gpad[:, -(CONV_B_W - 1):]

    ppad = jnp.concatenate([hist_p, c_u], axis=1)
    pooled = _multiscale_trailing_mean(ppad, pos0)
    d = (pooled - c_u.astype(jnp.float32)).astype(c_u.dtype).reshape(b, t, POOL_GROUPS, POOL_CH)
    mixed = jnp.einsum('btgc,gce->btge', d, pool_w).reshape(b, t, GROUP_W) + pool_bias
    y_c = mixed * pool_scale * jax.nn.silu(c_g)
    new_p = ppad[:, -POOL_HIST:]

    q = x_q.reshape(b, t, MEM_HEADS, MEM_HEAD_DIM)
    s = jnp.einsum('bthd,bmhd->bhtm', q, mem_k).astype(jnp.float32) * (MEM_HEAD_DIM ** -0.5)
    p = jax.nn.softmax(s, axis=-1).astype(mem_v.dtype)
    o = jnp.einsum('bhtm,bmhd->bthd', p, mem_v).reshape(b, t, GROUP_W)
    y_x = o * jax.nn.silu(x_g)

    y = jnp.concatenate([y_a, y_b, y_c, y_x], axis=-1)
    return x + jnp.einsum('bte,ed->btd', y, w_out), new_a, new_b, new_p


def setup_inputs(seed: int = 0) -> dict:
    key = jax.random.key(seed)
    ks = jax.random.split(key, 24)
    f = jnp.float32
    nrm = lambda k, shape, scale: jax.random.normal(k, shape, f) * scale
    return {
        'x_prompt': nrm(ks[0], (BATCH, SEQ, D_MODEL), 1.0),
        'x_sample': nrm(ks[1], (DEC_BATCH, DEC_SEQ, D_MODEL), 1.0),
        'mem_prompt': nrm(ks[2], (BATCH, N_MEM, D_MODEL), 1.0),
        'state_conv_a': nrm(ks[3], (DEPTH, DEC_BATCH, CONV_A_W - 1, GROUP_W), 1.0),
        'state_conv_b': nrm(ks[4], (DEPTH, DEC_BATCH, CONV_B_W - 1, GROUP_W), 1.0),
        'state_pool': nrm(ks[5], (DEPTH, DEC_BATCH, POOL_HIST, GROUP_W), 1.0),
        'cache_mem_k': nrm(ks[6], (DEPTH, DEC_BATCH, N_MEM, MEM_HEADS, MEM_HEAD_DIM), 1.0),
        'cache_mem_v': nrm(ks[7], (DEPTH, DEC_BATCH, N_MEM, MEM_HEADS, MEM_HEAD_DIM), 1.0),
        'norm_g': 1.0 + nrm(ks[8], (DEPTH, D_MODEL), 0.05),
        'w_in': nrm(ks[9], (DEPTH, D_MODEL, IN_COLS), D_MODEL ** -0.5),
        'conv_a_w': nrm(ks[10], (DEPTH, CONV_A_W, GROUP_W), CONV_A_W ** -0.5),
        'conv_b_w': nrm(ks[11], (DEPTH, CONV_B_W, GROUP_W), CONV_B_W ** -0.5),
        'conv_b_bias': nrm(ks[12], (DEPTH, GROUP_W), 0.02),
        'ln_b_g': 1.0 + nrm(ks[13], (DEPTH, GROUP_W), 0.05),
        'ln_b_b': nrm(ks[14], (DEPTH, GROUP_W), 0.02),
        'pool_w': nrm(ks[15], (DEPTH, POOL_GROUPS, POOL_CH, POOL_CH), POOL_CH ** -0.5),
        'pool_bias': nrm(ks[16], (DEPTH, GROUP_W), 0.02),
        'pool_scale': 1.0 + nrm(ks[17], (DEPTH, GROUP_W), 0.1),
        'mem_norm_g': 1.0 + nrm(ks[18], (DEPTH, D_MODEL), 0.05),
        'w_mem_k': nrm(ks[19], (DEPTH, D_MODEL, GROUP_W), D_MODEL ** -0.5),
        'w_mem_v': nrm(ks[20], (DEPTH, D_MODEL, GROUP_W), D_MODEL ** -0.5),
        'w_out': nrm(ks[21], (DEPTH, D_MIX, D_MODEL), D_MIX ** -0.5),
        'final_norm_g': 1.0 + nrm(ks[22], (D_MODEL,), 0.05),
    }


def reference(x_prompt, x_sample, mem_prompt, state_conv_a, state_conv_b, state_pool, cache_mem_k, cache_mem_v,
              norm_g, w_in, conv_a_w, conv_b_w, conv_b_bias, ln_b_g, ln_b_b, pool_w, pool_bias, pool_scale,
              mem_norm_g, w_mem_k, w_mem_v, w_out, final_norm_g):
    xp, xs = x_prompt, x_sample
    bp = xp.shape[0]
    na_p, nb_p, np_p, mk_p, mv_p = [], [], [], [], []
    na_s, nb_s, np_s = [], [], []
    for l in range(DEPTH):
        lp = (norm_g[l], w_in[l], conv_a_w[l], conv_b_w[l], conv_b_bias[l], ln_b_g[l], ln_b_b[l],
              pool_w[l], pool_bias[l], pool_scale[l], w_out[l])
        mk, mv = _mem_kv(mem_prompt, mem_norm_g[l], w_mem_k[l], w_mem_v[l])
        za = jnp.zeros((bp, CONV_A_W - 1, GROUP_W), xp.dtype)
        zb = jnp.zeros((bp, CONV_B_W - 1, GROUP_W), xp.dtype)
        zp = jnp.zeros((bp, POOL_HIST, GROUP_W), xp.dtype)
        xp, a1, b1, p1 = _layer(xp, za, zb, zp, mk, mv, 0, lp)
        na_p.append(a1); nb_p.append(b1); np_p.append(p1); mk_p.append(mk); mv_p.append(mv)
        xs, a2, b2, p2 = _layer(xs, state_conv_a[l], state_conv_b[l], state_pool[l],
                                cache_mem_k[l], cache_mem_v[l], PAST_LEN, lp)
        na_s.append(a2); nb_s.append(b2); np_s.append(p2)
    y_prompt = _rmsnorm(xp, final_norm_g)
    y_sample = _rmsnorm(xs, final_norm_g)
    return (y_prompt, y_sample,
            jnp.stack(na_p), jnp.stack(nb_p), jnp.stack(np_p), jnp.stack(mk_p), jnp.stack(mv_p),
            jnp.stack(na_s), jnp.stack(nb_s), jnp.stack(np_s))
```

```cpp
#include <hip/hip_runtime.h>
#include <hip/hip_cooperative_groups.h>
#include <cstdio>
#include <cstdint>
namespace cg = cooperative_groups;
namespace pg8 {
#define PG8_LAS __attribute__((address_space(3)))
typedef unsigned short bf16_t;
typedef short bf16x8 __attribute__((ext_vector_type(8)));
typedef float f32x4 __attribute__((ext_vector_type(4)));
typedef unsigned u32x4 __attribute__((ext_vector_type(4)));
constexpr int BM = 256, BK = 64, HALF = 128, HTB = HALF * BK * 2  , STAGE_BYTES = 8 * HTB, NXCD = 8, WGM = 8;

__host__ __device__ __forceinline__ int lds_byte(int r, int c) { const int st = (r >> 4) * 2 + (c >> 5), rr = r & 15, cc = c & 31, ob = rr * 64 + cc * 2; return st * 1024 + (ob ^ (((ob >> 9) & 1) << 5)); }
__host__ __device__ __forceinline__ void stage_rc(int b, int& R, int& C) { const int st = b / 1024, sb = b % 1024, swz = sb ^ (((sb >> 9) & 1) << 5); R = (st >> 1) * 16 + swz / 64; C = (st & 1) * 32 + (swz % 64) / 2; }
__host__ __device__ __forceinline__ int perm32(int rho) { const int n = rho >> 4, i = rho & 15; return 8 * (i >> 2) + 4 * n + (i & 3); }

struct Unit { int pm, pn; };
struct Gemm { const bf16_t* A; const bf16_t* Bt; int M, N, K; };

struct StaticOrder {
    int nM, nN, nwg, G, c;
    __host__ __device__ void init(int M, int N, int G_, int c_) { nM = M / BM; nN = N / BM; nwg = nM * nN; G = G_; c = c_; }
    __host__ __device__ bool next(int i, Unit& u) const {
        const long L = (long)i * G + c; if (L >= nwg) return false;
        int wgid = (int)L; { const int q = nwg / NXCD, r = nwg % NXCD, xcd = wgid % NXCD, off = wgid / NXCD; wgid = (xcd < r ? xcd * (q + 1) : r * (q + 1) + (xcd - r) * q) + off; }
        const int nig = WGM * nN, gid = wgid / nig, fm = gid * WGM, gsz = (nM - fm) < WGM ? (nM - fm) : WGM;
        u.pm = fm + ((wgid % nig) % gsz); u.pn = (wgid % nig) / gsz; return true;
    }
    __device__ __forceinline__ void a_ready(const Unit&) const {}
    __device__ __forceinline__ void done(const Unit&) const {}
};
__device__ __forceinline__ unsigned cvt_pk_bf16(float lo, float hi) { unsigned r; asm volatile("v_cvt_pk_bf16_f32 %0, %1, %2" : "=v"(r) : "v"(lo), "v"(hi)); return r; }
template <class Epi, class Sched, bool ALIGN_EPI = false, bool SP2 = false>
__device__ __forceinline__ void gemm_phase(PG8_LAS unsigned char* lds, const Gemm g, const Sched& S, const Epi& E) {
    const int tid = threadIdx.x, wid = __builtin_amdgcn_readfirstlane(tid >> 6), lane = tid & 63, wr = wid >> 2, wc = wid & 3, fr = lane & 15, fq = lane >> 4;
    const int K = g.K, nt = K / BK;
    unsigned voffA[2], voffB[2];
#pragma unroll
    for (int i = 0; i < 2; ++i) { int R, C; stage_rc(tid * 16 + i * 8192, R, C); const int Rb = Epi::PERM ? ((R & ~31) + perm32(R & 31)) : R;
        voffA[i] = (unsigned)(R * K + C) * 2u; voffB[i] = (unsigned)(Rb * K + C) * 2u; }
    const size_t kstep = (size_t)(BK * 2);
    const size_t hstep = (size_t)HALF * K * 2;
    const size_t tstep = 2 * hstep;
    const unsigned ldsw = (unsigned)wid * 1024u;
    const int aoff = lds_byte(wr * 64 + fr, fq * 8), boff = lds_byte(wc * 32 + fr, fq * 8);
#define PG8_SA(b, h) (((b) * 2 + (h)) * HTB)
#define PG8_SB(b, h) ((4 + (b) * 2 + (h)) * HTB)
#define PG8_STAGE(bufoff, gbase, voff) do { _Pragma("unroll") for (int _i = 0; _i < 2; ++_i) \
        __builtin_amdgcn_global_load_lds((const unsigned*)((const char*)(gbase) + (voff)[_i]), (PG8_LAS unsigned*)(lds + (bufoff) + ldsw + _i * 8192), 16, 0, 0); } while (0)
#define PG8_LDA(dst, b, h) do { _Pragma("unroll") for (int m = 0; m < 4; ++m) _Pragma("unroll") for (int k = 0; k < 2; ++k) dst[m][k] = *(const PG8_LAS bf16x8*)(lds + PG8_SA(b, h) + aoff + m * 2048 + k * 1024); } while (0)
#define PG8_LDB(dst, b, h) do { _Pragma("unroll") for (int n = 0; n < 2; ++n) _Pragma("unroll") for (int k = 0; k < 2; ++k) dst[n][k] = *(const PG8_LAS bf16x8*)(lds + PG8_SB(b, h) + boff + n * 2048 + k * 1024); } while (0)
#define PG8_MMA(ai, bj, At, Bt) do { __builtin_amdgcn_s_setprio(1); _Pragma("unroll") for (int m = 0; m < 4; ++m) _Pragma("unroll") for (int n = 0; n < 2; ++n) _Pragma("unroll") for (int k = 0; k < 2; ++k) \
        acc[ai][bj][m][n] = __builtin_amdgcn_mfma_f32_16x16x32_bf16(Bt[n][k], At[m][k], acc[ai][bj][m][n], 0, 0, 0); __builtin_amdgcn_s_setprio(0); } while (0)
#define PG8_WAIT_V(n) asm volatile("s_waitcnt vmcnt(" #n ")" ::: "memory")
#define PG8_WAIT_L(n) asm volatile("s_waitcnt lgkmcnt(" #n ")" ::: "memory")
#define PG8_BAR __builtin_amdgcn_s_barrier()
#define PG8_SCHED __builtin_amdgcn_sched_barrier(0)
    Unit cur, nxt; int ui = 0;
    if (!S.next(0, cur)) return;
    f32x4 acc[2][2][4][2];
#pragma unroll
    for (int a = 0; a < 2; ++a)
#pragma unroll
        for (int b = 0; b < 2; ++b)
#pragma unroll
            for (int m = 0; m < 4; ++m)
#pragma unroll
                for (int n = 0; n < 2; ++n) acc[a][b][m][n] = (f32x4){0.f, 0.f, 0.f, 0.f};
    bf16x8 At[4][2], B0[2][2], B1[2][2];
    const char* cA = (const char*)g.A + (size_t)cur.pm * tstep; const char* cB = (const char*)g.Bt + (size_t)cur.pn * tstep;
    S.a_ready(cur);
    if constexpr (SP2) {
        PG8_STAGE(PG8_SB(0, 0), cB, voffB); PG8_STAGE(PG8_SB(0, 1), cB + hstep, voffB); PG8_STAGE(PG8_SA(0, 0), cA, voffA); PG8_STAGE(PG8_SA(0, 1), cA + hstep, voffA);
        if (wr == 1) PG8_BAR;
        PG8_WAIT_V(2); PG8_BAR;
        PG8_STAGE(PG8_SB(1, 0), cB + kstep, voffB); PG8_STAGE(PG8_SA(1, 0), cA + kstep, voffA); PG8_STAGE(PG8_SB(1, 1), cB + hstep + kstep, voffB);
        PG8_WAIT_V(6); PG8_BAR;
    } else {
        PG8_STAGE(PG8_SB(0, 0), cB, voffB); PG8_STAGE(PG8_SA(0, 0), cA, voffA); PG8_STAGE(PG8_SB(0, 1), cB + hstep, voffB); PG8_STAGE(PG8_SA(0, 1), cA + hstep, voffA);
        if (wr == 1) PG8_BAR;
        PG8_WAIT_V(4); PG8_BAR;
        PG8_STAGE(PG8_SB(1, 0), cB + kstep, voffB); PG8_STAGE(PG8_SA(1, 0), cA + kstep, voffA); PG8_STAGE(PG8_SB(1, 1), cB + hstep + kstep, voffB);
        PG8_WAIT_V(6); PG8_BAR;
    }
    for (;;) {
        const bool has_next = S.next(ui + 1, nxt);
        const char* nA = has_next ? (const char*)g.A + (size_t)nxt.pm * tstep : cA; const char* nB = has_next ? (const char*)g.Bt + (size_t)nxt.pn * tstep : cB;
        for (int t = 0; t < nt; t += 2) {
            const bool last = (t == nt - 2);
            const char* a1 = cA + (size_t)(t + 1) * kstep;
            const char* a2 = last ? nA : cA + (size_t)(t + 2) * kstep; const char* b2 = last ? nB : cB + (size_t)(t + 2) * kstep;
            const char* a3 = a2 + kstep; const char* b3 = b2 + kstep;
            if (last && has_next) S.a_ready(nxt);
            if constexpr (SP2) {
            PG8_LDB(B0, 0, 0); PG8_LDB(B1, 0, 1); PG8_SCHED; PG8_LDA(At, 0, 0); PG8_STAGE(PG8_SA(1, 1), a1 + hstep, voffA);
            PG8_WAIT_V(8); PG8_WAIT_L(0); PG8_BAR; PG8_MMA(0, 0, At, B0); PG8_MMA(0, 1, At, B1); PG8_BAR; PG8_SCHED;
            PG8_LDA(At, 0, 1); PG8_STAGE(PG8_SB(0, 0), b2, voffB); PG8_STAGE(PG8_SB(0, 1), b2 + hstep, voffB); PG8_STAGE(PG8_SA(0, 0), a2, voffA);
            PG8_WAIT_V(8); PG8_WAIT_L(0); PG8_BAR; PG8_MMA(1, 0, At, B0); PG8_MMA(1, 1, At, B1); PG8_BAR; PG8_SCHED;
            PG8_LDB(B0, 1, 0); PG8_LDB(B1, 1, 1); PG8_SCHED; PG8_LDA(At, 1, 0); PG8_STAGE(PG8_SA(0, 1), a2 + hstep, voffA);
            PG8_WAIT_V(8); PG8_WAIT_L(0); PG8_BAR; PG8_MMA(0, 0, At, B0); PG8_MMA(0, 1, At, B1); PG8_BAR; PG8_SCHED;
            PG8_LDA(At, 1, 1); PG8_STAGE(PG8_SB(1, 0), b3, voffB); PG8_STAGE(PG8_SB(1, 1), b3 + hstep, voffB); PG8_STAGE(PG8_SA(1, 0), a3, voffA);
            PG8_WAIT_V(8); PG8_WAIT_L(0); PG8_BAR; PG8_MMA(1, 0, At, B0); PG8_MMA(1, 1, At, B1); PG8_BAR; PG8_SCHED;
            } else {
            PG8_LDB(B0, 0, 0); PG8_SCHED; PG8_LDA(At, 0, 0); PG8_STAGE(PG8_SA(1, 1), a1 + hstep, voffA);
            PG8_WAIT_L(8); PG8_BAR; PG8_WAIT_L(0); PG8_MMA(0, 0, At, B0); PG8_BAR; PG8_SCHED;
            PG8_LDB(B1, 0, 1); PG8_STAGE(PG8_SB(0, 0), b2, voffB);
            PG8_BAR; PG8_WAIT_L(0); PG8_MMA(0, 1, At, B1); PG8_BAR;
            PG8_LDA(At, 0, 1); PG8_STAGE(PG8_SA(0, 0), a2, voffA);
            PG8_BAR; PG8_WAIT_L(0); PG8_MMA(1, 0, At, B0); PG8_BAR; PG8_SCHED;
            PG8_STAGE(PG8_SB(0, 1), b2 + hstep, voffB);
            PG8_WAIT_V(6); PG8_BAR; PG8_MMA(1, 1, At, B1); PG8_BAR;
            PG8_LDB(B0, 1, 0); PG8_SCHED; PG8_LDA(At, 1, 0); PG8_STAGE(PG8_SA(0, 1), a2 + hstep, voffA);
            PG8_WAIT_L(8); PG8_BAR; PG8_WAIT_L(0); PG8_MMA(0, 0, At, B0); PG8_BAR; PG8_SCHED;
            PG8_LDB(B1, 1, 1); PG8_STAGE(PG8_SB(1, 0), b3, voffB);
            PG8_BAR; PG8_WAIT_L(0); PG8_MMA(0, 1, At, B1); PG8_BAR;
            PG8_LDA(At, 1, 1); PG8_STAGE(PG8_SA(1, 0), a3, voffA);
            PG8_BAR; PG8_WAIT_L(0); PG8_MMA(1, 0, At, B0); PG8_BAR; PG8_SCHED;
            PG8_STAGE(PG8_SB(1, 1), b3 + hstep, voffB);
            PG8_WAIT_V(6); PG8_BAR; PG8_MMA(1, 1, At, B1); PG8_BAR;
            }
        }
        if constexpr (ALIGN_EPI) { if (wr == 0) PG8_BAR; }
        if constexpr (!Epi::AFTER_DRAIN) { E(acc, cur, wr, wc, fr, fq); S.done(cur); }
        if (!has_next) break;
#pragma unroll
        for (int a = 0; a < 2; ++a)
#pragma unroll
            for (int b = 0; b < 2; ++b)
#pragma unroll
                for (int m = 0; m < 4; ++m)
#pragma unroll
                    for (int n = 0; n < 2; ++n) acc[a][b][m][n] = (f32x4){0.f, 0.f, 0.f, 0.f};
        cur = nxt; cA = nA; cB = nB; ++ui;
        if constexpr (ALIGN_EPI) { if (wr == 1) PG8_BAR; }
    }
    PG8_WAIT_V(0);
    if constexpr (!ALIGN_EPI) { if (wr == 0) PG8_BAR; }
    PG8_BAR;
    if constexpr (Epi::AFTER_DRAIN) { E.fused(acc, cur, wr, wc, fr, fq, lds, wid, lane); S.done(cur); }
#undef PG8_SA
#undef PG8_SB
#undef PG8_STAGE
#undef PG8_LDA
#undef PG8_LDB
#undef PG8_MMA
#undef PG8_WAIT_V
#undef PG8_WAIT_L
#undef PG8_BAR
#undef PG8_SCHED
}
}

#define LAS __attribute__((address_space(3)))
typedef unsigned short bf16;
typedef unsigned v4u __attribute__((ext_vector_type(4)));
typedef unsigned v2u __attribute__((ext_vector_type(2)));
typedef float f32x4 __attribute__((ext_vector_type(4)));
typedef short bf16x8 __attribute__((ext_vector_type(8)));

constexpr int D = 1024, NPR = 32768, NSR = 2048, M = NPR + NSR, NC = 2816, NSEQ = 36, NTILE = M / 64;
constexpr float EPS = 1e-6f;
constexpr size_t O_Y = 0, O_NAP = 35651584, O_NBP = O_NAP + 4096, O_NPP = O_NBP + 61440, O_MKP = O_NPP + 30720, O_MVP = O_MKP + 524288,
                 O_NAS = O_MVP + 524288, O_NBS = O_NAS + 32768, O_NPS = O_NBS + 491520, O_END = O_NPS + 245760;
constexpr size_t MiB = 1u << 20;
constexpr size_t WS_WIN = 0, WS_WOUT = 12 * MiB, WS_WMEM = 16 * MiB, WS_PWT = 18 * MiB, WS_RSM = 18 * MiB + 65536, WS_SSPA = 19 * MiB, WS_SSPB = 22 * MiB,
                 WS_CTL = 24 * MiB + 512 * 1024, WS_MNB = 25 * MiB, WS_KB = 28 * MiB, WS_VT = 38 * MiB, WS_XB = 48 * MiB, WS_Y = 116 * MiB, WS_U = 184 * MiB, WS_END = 372 * MiB;
constexpr int LDS_BYTES = 135168;

struct Params { const float* in[23]; float* out; unsigned char* ws; };

__device__ __forceinline__ unsigned cvtpk(float lo, float hi) { unsigned r; asm("v_cvt_pk_bf16_f32 %0, %1, %2" : "=v"(r) : "v"(lo), "v"(hi)); return r; }
__device__ __forceinline__ float bflo(unsigned u) { return __uint_as_float(u << 16); }
__device__ __forceinline__ float bfhi(unsigned u) { return __uint_as_float(u & 0xffff0000u); }
__device__ __forceinline__ float bf1(bf16 b) { return __uint_as_float(((unsigned)b) << 16); }
__device__ __forceinline__ float sigm(float x) { return __builtin_amdgcn_rcpf(1.f + __builtin_amdgcn_exp2f(-1.44269504f * x)); }
__device__ __forceinline__ float silu(float x) { return x * sigm(x); }
__device__ __forceinline__ void unpack8(v4u u, float (&f)[8]) { f[0] = bflo(u.x); f[1] = bfhi(u.x); f[2] = bflo(u.y); f[3] = bfhi(u.y); f[4] = bflo(u.z); f[5] = bfhi(u.z); f[6] = bflo(u.w); f[7] = bfhi(u.w); }
__device__ __forceinline__ v4u pack8(const float (&f)[8]) { v4u o; o.x = cvtpk(f[0], f[1]); o.y = cvtpk(f[2], f[3]); o.z = cvtpk(f[4], f[5]); o.w = cvtpk(f[6], f[7]); return o; }
__device__ __forceinline__ float wave_sum(float v) {
#pragma unroll
    for (int o = 1; o < 64; o <<= 1) v += __shfl_xor(v, o);
    return v;
}
#define LDS_WAIT() asm volatile("s_waitcnt lgkmcnt(0)" ::: "memory")

struct EpiU {
    static constexpr bool PERM = true, AFTER_DRAIN = false;
    bf16* U; const float* ssp;
    __device__ __forceinline__ void operator()(const f32x4 (&acc)[2][2][4][2], const pg8::Unit& u, int wr, int wc, int fr, int fq) const {
        const int row0 = u.pm * 256 + wr * 64 + fr, pn = u.pn, lc = wc * 32 + 8 * fq;
        float rs[2][4];
        {
            f32x4 sq[2][4];
#pragma unroll
            for (int ai = 0; ai < 2; ++ai)
#pragma unroll
                for (int m = 0; m < 4; ++m) sq[ai][m] = *(const f32x4*)(ssp + (size_t)(row0 + ai * 128 + m * 16) * 16 + fq * 4);
#pragma unroll
            for (int ai = 0; ai < 2; ++ai)
#pragma unroll
                for (int m = 0; m < 4; ++m) {
                    float t = (sq[ai][m].x + sq[ai][m].y) + (sq[ai][m].z + sq[ai][m].w);
                    t += __shfl_xor(t, 16); t += __shfl_xor(t, 32);
                    rs[ai][m] = rsqrtf(t * (1.0f / 1024.0f) + EPS);
                }
        }
#pragma unroll
        for (int ai = 0; ai < 2; ++ai)
#pragma unroll
            for (int m = 0; m < 4; ++m) {
                const int row = row0 + ai * 128 + m * 16;
                const float rstd = rs[ai][m];
                bf16* rowp = U + (size_t)row * 2048;
                if (pn < 6) {
                    const f32x4 a0 = acc[ai][0][m][0] * rstd, a1 = acc[ai][0][m][1] * rstd, g0 = acc[ai][1][m][0] * rstd, g1 = acc[ai][1][m][1] * rstd;
                    float o[8];
                    if ((pn >> 1) == 0) {
#pragma unroll
                        for (int j = 0; j < 4; ++j) { o[j] = a0[j] * silu(g0[j]); o[4 + j] = a1[j] * silu(g1[j]); }
                    } else if ((pn >> 1) == 1) {
#pragma unroll
                        for (int j = 0; j < 4; ++j) { o[j] = a0[j] * g0[j]; o[4 + j] = a1[j] * g1[j]; }
                    } else {
#pragma unroll
                        for (int j = 0; j < 4; ++j) { o[j] = a0[j] * sigm(g0[j]); o[4 + j] = a1[j] * sigm(g1[j]); }
                    }
                    *(v4u*)(rowp + (pn >> 1) * 256 + (pn & 1) * 128 + lc) = pack8(o);
                } else {
                    const float sc = (pn == 9) ? rstd * (0.125f * 1.44269504f) : rstd;
                    const bool act = (pn & 1) == 0;
#pragma unroll
                    for (int bj = 0; bj < 2; ++bj) {
                        const f32x4 v0 = acc[ai][bj][m][0] * sc, v1 = acc[ai][bj][m][1] * sc;
                        float o[8];
#pragma unroll
                        for (int j = 0; j < 4; ++j) { o[j] = act ? silu(v0[j]) : v0[j]; o[4 + j] = act ? silu(v1[j]) : v1[j]; }
                        *(v4u*)(rowp + 768 + (pn - 6) * 256 + bj * 128 + lc) = pack8(o);
                    }
                }
            }
    }
};
struct EpiX {
    static constexpr bool PERM = true, AFTER_DRAIN = false;
    bf16* XB; float* ssp; bf16* XO;
    __device__ __forceinline__ void operator()(const f32x4 (&acc)[2][2][4][2], const pg8::Unit& u, int wr, int wc, int fr, int fq) const {
        const int row0 = u.pm * 256 + wr * 64 + fr, col0 = u.pn * 256 + wc * 32 + 8 * fq;
#pragma unroll
        for (int ai = 0; ai < 2; ++ai) {
            v4u xv[4][2];
#pragma unroll
            for (int m = 0; m < 4; ++m)
#pragma unroll
                for (int bj = 0; bj < 2; ++bj) xv[m][bj] = *(const v4u*)(XB + (size_t)(row0 + ai * 128 + m * 16) * D + col0 + bj * 128);
#pragma unroll
            for (int m = 0; m < 4; ++m) {
                const int row = row0 + ai * 128 + m * 16;
                float ss = 0.f;
#pragma unroll
                for (int bj = 0; bj < 2; ++bj) {
                    float xo[8]; unpack8(xv[m][bj], xo);
                    const f32x4 a0 = acc[ai][bj][m][0], a1 = acc[ai][bj][m][1];
#pragma unroll
                    for (int j = 0; j < 4; ++j) { xo[j] += a0[j]; xo[4 + j] += a1[j]; }
#pragma unroll
                    for (int j = 0; j < 8; ++j) ss += xo[j] * xo[j];
                    *(v4u*)(XO + (size_t)row * D + col0 + bj * 128) = pack8(xo);
                }
                ss += __shfl_xor(ss, 16); ss += __shfl_xor(ss, 32);
                if (fq == 0) ssp[(size_t)row * 16 + u.pn * 4 + wc] = ss;
            }
        }
    }
};
struct EpiKV {
    static constexpr bool PERM = false, AFTER_DRAIN = true;
    const float* rsm; float* out; bf16* KB; bf16* VT;
    __device__ __forceinline__ void operator()(const f32x4 (&)[2][2][4][2], const pg8::Unit&, int, int, int, int) const {}
    __device__ __forceinline__ void fused(f32x4 (&acc)[2][2][4][2], const pg8::Unit& u, int wr, int wc, int fr, int fq, PG8_LAS unsigned char* lds, int wid, int lane) const {
        const int l = u.pn >> 1, isv = u.pn & 1, b = u.pm;
        const int mem0 = wr * 64 + fr, c0 = wc * 32 + 4 * fq;
        float* ob = out + O_MKP + (size_t)isv * (O_MVP - O_MKP) + (size_t)(l * 4 + b) * 65536;
        PG8_LAS bf16* img = (PG8_LAS bf16*)lds;
#pragma unroll
        for (int ai = 0; ai < 2; ++ai)
#pragma unroll
            for (int m = 0; m < 4; ++m) {
                const int mem = mem0 + ai * 128 + m * 16;
                const float rs = rsm[b * 256 + mem];
#pragma unroll
                for (int bj = 0; bj < 2; ++bj)
#pragma unroll
                    for (int n = 0; n < 2; ++n) {
                        const int c = c0 + bj * 128 + n * 16;
                        const f32x4 v = acc[ai][bj][m][n] * rs;
                        *(f32x4*)(ob + (size_t)mem * 256 + c) = v;
                        const int h = c >> 6, d = c & 63;
                        const unsigned w0 = cvtpk(v[0], v[1]), w1 = cvtpk(v[2], v[3]);
                        if (!isv) {
                            const int mt = (mem >> 5) * 2 + ((mem >> 2) & 1), r = ((mem >> 3) & 3) * 4 + (mem & 3), kk = d >> 5, q = (d >> 3) & 3, e = d & 7;
                            *(PG8_LAS v2u*)(img + ((h * 32 + mt * 2 + kk) * 512 + (q * 16 + r) * 8 + e)) = (v2u){w0, w1};
                        } else {
                            const int mp = mem >> 5, q = (mem >> 3) & 3, e = mem & 7, dt = d >> 4, r = d & 15;
                            PG8_LAS bf16* vp = img + ((h * 32 + mp * 4 + dt) * 512 + (q * 16 + r) * 8 + e);
                            vp[0] = (bf16)(w0 & 0xffffu); vp[8] = (bf16)(w0 >> 16); vp[16] = (bf16)(w1 & 0xffffu); vp[24] = (bf16)(w1 >> 16);
                        }
                    }
            }
        asm volatile("s_waitcnt lgkmcnt(0)" ::: "memory"); __builtin_amdgcn_s_barrier(); asm volatile("" ::: "memory");
        bf16* dst = KB + (ptrdiff_t)isv * (VT - KB) + (size_t)(l * NSEQ + b) * 65536;
        const int tid = wid * 64 + lane;
#pragma unroll
        for (int i = 0; i < 16; ++i) { const int ch = tid + 512 * i; *(v4u*)(dst + (size_t)ch * 8) = *(const PG8_LAS v4u*)(img + ch * 8); }
        asm volatile("s_waitcnt lgkmcnt(0)" ::: "memory"); __builtin_amdgcn_s_barrier(); asm volatile("" ::: "memory");
    }
};

__device__ __forceinline__ void transpose_item(const float* W, int K, int N, bf16* WT, int row_off, const float* gs, LAS float* scr, int item, int lane, bool remap = false) {
    const int nblk = N / 32, kb = item / nblk, nb = item % nblk, k0 = 64 * kb, n0 = 32 * nb;
    int d0 = n0;
    if (remap) { const int sp = n0 >> 8, ch = n0 & 255; if (sp < 6) { const int pair = (sp == 0 || sp == 3) ? 0 : ((sp == 1 || sp == 2) ? 1 : 2), bj = (sp == 3 || sp == 2 || sp == 5) ? 1 : 0; d0 = (pair * 2 + (ch >> 7)) * 256 + bj * 128 + (ch & 127); } }
    f32x4 tv[8];
#pragma unroll
    for (int i = 0; i < 8; ++i) { const int kk = 8 * i + (lane >> 3); tv[i] = *(const f32x4*)(W + (size_t)(k0 + kk) * N + n0 + (lane & 7) * 4); }
#pragma unroll
    for (int i = 0; i < 8; ++i) { const int kk = 8 * i + (lane >> 3); f32x4 v = tv[i]; if (gs) v = v * gs[k0 + kk];
        LAS float* d = scr + kk * 33 + (lane & 7) * 4; d[0] = v.x; d[1] = v.y; d[2] = v.z; d[3] = v.w; }
    LDS_WAIT();
    const int c = lane & 7;
#pragma unroll
    for (int j = 0; j < 4; ++j) { const int n = (lane >> 3) + 8 * j; const LAS float* s = scr + (8 * c) * 33 + n;
        v4u o; o.x = cvtpk(s[0 * 33], s[1 * 33]); o.y = cvtpk(s[2 * 33], s[3 * 33]); o.z = cvtpk(s[4 * 33], s[5 * 33]); o.w = cvtpk(s[6 * 33], s[7 * 33]);
        *(v4u*)(WT + (size_t)(row_off + d0 + n) * K + k0 + 8 * c) = o; }
    LDS_WAIT();
}
__device__ __forceinline__ float row_to_bf16(const float* xrow, bf16* orow, int lane) {
    const f32x4* xr = (const f32x4*)xrow + lane;
    f32x4 v[4]; float s = 0.f;
#pragma unroll
    for (int j = 0; j < 4; ++j) { v[j] = xr[64 * j]; s += (v[j].x * v[j].x + v[j].y * v[j].y) + (v[j].z * v[j].z + v[j].w * v[j].w); }
    s = wave_sum(s);
    v2u* o8 = (v2u*)orow + lane;
#pragma unroll
    for (int j = 0; j < 4; ++j) { v2u w; w.x = cvtpk(v[j].x, v[j].y); w.y = cvtpk(v[j].z, v[j].w); o8[64 * j] = w; }
    return s;
}

constexpr int UC = 2048, C_ABG = 0, C_V = 256, C_GLU = 512, C_SBG = 768, C_CU = 1024, C_SCG = 1280, C_Q = 1536, C_SXG = 1792;
struct Lay {
    const bf16* U; bf16* Y; const bf16* KB; const bf16* VT; const bf16* PWT;
    const float *caw, *cbw, *cbb, *lng, *lnb, *pbias, *pscale, *sta, *stb, *stp;
    float* out; int l;
};
struct Tile { int row0, seq, t0, first, last, samp, b; };
__device__ __forceinline__ Tile mk_tile(int tt) {
    Tile T; T.row0 = tt * 64;
    if (tt < 512) { T.seq = tt >> 7; T.t0 = (tt & 127) * 64; T.first = (tt & 127) == 0; T.last = (tt & 127) == 127; T.samp = 0; T.b = T.seq; }
    else { T.seq = 4 + (tt - 512); T.t0 = 0; T.first = 1; T.last = 1; T.samp = 1; T.b = tt - 512; }
    return T;
}
__device__ __forceinline__ void ld8f(const float* s, float (&f)[8]) { const f32x4 a = *(const f32x4*)s, b = *(const f32x4*)(s + 4); f[0] = a.x; f[1] = a.y; f[2] = a.z; f[3] = a.w; f[4] = b.x; f[5] = b.y; f[6] = b.z; f[7] = b.w; }

__device__ __forceinline__ void mix_a(const Lay& L, const Tile& T, int tid) {
    asm volatile("" : "+v"(tid));
    const int c0 = (tid & 31) * 8, tq = tid >> 5;
    const bf16* ub = L.U + (size_t)(T.row0 + tq * 4) * UC + c0;
    const bool hist = T.first && tq == 0;
    v4u rv[6], rb[4];
#pragma unroll
    for (int jj = 0; jj < 6; ++jj) rv[jj] = (jj >= 2 || !hist) ? __builtin_nontemporal_load((const v4u*)(ub + (jj - 2) * UC + C_V)) : (v4u){0u, 0u, 0u, 0u};
#pragma unroll
    for (int j = 0; j < 4; ++j) rb[j] = __builtin_nontemporal_load((const v4u*)(ub + j * UC + C_ABG));
    float w[3][8];
#pragma unroll
    for (int k = 0; k < 3; ++k) ld8f(L.caw + k * 256 + c0, w[k]);
    float v[6][8];
#pragma unroll
    for (int jj = 0; jj < 6; ++jj) unpack8(rv[jj], v[jj]);
    if (hist && T.samp) { ld8f(L.sta + ((size_t)T.b * 2 + 0) * 256 + c0, v[0]); ld8f(L.sta + ((size_t)T.b * 2 + 1) * 256 + c0, v[1]); }
#pragma unroll
    for (int j = 0; j < 4; ++j) {
        float fb[8], y[8]; unpack8(rb[j], fb);
#pragma unroll
        for (int i = 0; i < 8; ++i) y[i] = fb[i] * (w[0][i] * v[j][i] + w[1][i] * v[j + 1][i] + w[2][i] * v[j + 2][i]);
        *(v4u*)(L.Y + (size_t)(T.row0 + tq * 4 + j) * D + c0) = pack8(y);
    }
    if (T.last && tq == 15) {
#pragma unroll
        for (int j2 = 0; j2 < 2; ++j2) {
            float* dst = L.out + (T.samp ? O_NAS + ((size_t)(L.l * 32 + T.b) * 2 + j2) * 256 : O_NAP + ((size_t)(L.l * 4 + T.b) * 2 + j2) * 256) + c0;
            *(f32x4*)dst = (f32x4){v[4 + j2][0], v[4 + j2][1], v[4 + j2][2], v[4 + j2][3]};
            *(f32x4*)(dst + 4) = (f32x4){v[4 + j2][4], v[4 + j2][5], v[4 + j2][6], v[4 + j2][7]};
        }
    }
}

__device__ __forceinline__ void mix_b(const Lay& L, const Tile& T, int tid, LAS unsigned char* lds) {
    asm volatile("" : "+v"(tid));
    LAS float* G = (LAS float*)lds;
    LAS float* red = (LAS float*)(lds + 98304);
    LAS bf16* SB = (LAS bf16*)(lds + 100352);
    LAS float* stat = (LAS float*)(lds + 133632);
    const int c = tid & 255, th = tid >> 8, lane = tid & 63, wq = (tid >> 6) & 3;
    float w[31];
    {
        v4u rg[6], rs[4];
#pragma unroll
        for (int k = 0; k < 6; ++k) {
            const int i = tid + 512 * k, r = i >> 5, c0 = (i & 31) * 8, tt = r - 30;
            rg[k] = (i < 94 * 32 && (tt >= 0 || !T.first)) ? __builtin_nontemporal_load((const v4u*)(L.U + (size_t)(T.row0 + tt) * UC + C_GLU + c0)) : (v4u){0u, 0u, 0u, 0u};
        }
#pragma unroll
        for (int k = 0; k < 4; ++k) { const int i = tid + 512 * k, r = i >> 5, c0 = (i & 31) * 8; rs[k] = __builtin_nontemporal_load((const v4u*)(L.U + (size_t)(T.row0 + r) * UC + C_SBG + c0)); }
#pragma unroll
        for (int k = 0; k < 31; ++k) w[k] = L.cbw[k * 256 + c];
#pragma unroll
        for (int k = 0; k < 6; ++k) {
            const int i = tid + 512 * k, r = i >> 5, c0 = (i & 31) * 8, tt = r - 30;
            if (i < 94 * 32) {
                float g8[8]; unpack8(rg[k], g8);
                if (tt < 0 && T.first && T.samp) ld8f(L.stb + ((size_t)T.b * 30 + r) * 256 + c0, g8);
                *(LAS f32x4*)(G + r * 256 + c0) = (f32x4){g8[0], g8[1], g8[2], g8[3]};
                *(LAS f32x4*)(G + r * 256 + c0 + 4) = (f32x4){g8[4], g8[5], g8[6], g8[7]};
            }
        }
#pragma unroll
        for (int k = 0; k < 4; ++k) { const int i = tid + 512 * k; *(LAS v4u*)(SB + i * 8) = rs[k]; }
    }
    __syncthreads();
    const float bias = L.cbb[c];
    float z[4][8];
    {
        float g[62];
#pragma unroll
        for (int i = 0; i < 62; ++i) g[i] = G[(th * 32 + i) * 256 + c];
#pragma unroll
        for (int ch = 0; ch < 4; ++ch)
#pragma unroll
            for (int j = 0; j < 8; ++j) {
                float a = bias;
#pragma unroll
                for (int k = 0; k < 31; ++k) a += w[k] * g[ch * 8 + j + k];
                z[ch][j] = a;
            }
    }
    const bool b5 = (lane & 32) != 0, b4 = (lane & 16) != 0, b3 = (lane & 8) != 0;
#pragma unroll
    for (int ch = 0; ch < 4; ++ch) {
        const int tb = th * 32 + ch * 8;
        float r1[4], r2[4];
#pragma unroll
        for (int i = 0; i < 4; ++i) {
            const float za = z[ch][i], zb = z[ch][4 + i];
            const float k1 = b5 ? zb : za, s1 = b5 ? za : zb;
            r1[i] = k1 + __shfl_xor(s1, 32);
            const float k2 = b5 ? zb * zb : za * za, s2 = b5 ? za * za : zb * zb;
            r2[i] = k2 + __shfl_xor(s2, 32);
        }
        float q1[2], q2[2];
#pragma unroll
        for (int i = 0; i < 2; ++i) {
            const float k1 = b4 ? r1[2 + i] : r1[i], s1 = b4 ? r1[i] : r1[2 + i];
            q1[i] = k1 + __shfl_xor(s1, 16);
            const float k2 = b4 ? r2[2 + i] : r2[i], s2 = b4 ? r2[i] : r2[2 + i];
            q2[i] = k2 + __shfl_xor(s2, 16);
        }
        float d1 = (b3 ? q1[1] : q1[0]) + __shfl_xor(b3 ? q1[0] : q1[1], 8);
        float d2 = (b3 ? q2[1] : q2[0]) + __shfl_xor(b3 ? q2[0] : q2[1], 8);
        d1 += __shfl_xor(d1, 4); d1 += __shfl_xor(d1, 2); d1 += __shfl_xor(d1, 1);
        d2 += __shfl_xor(d2, 4); d2 += __shfl_xor(d2, 2); d2 += __shfl_xor(d2, 1);
        if ((lane & 7) == 0) { red[(tb + (lane >> 3)) * 8 + wq * 2] = d1; red[(tb + (lane >> 3)) * 8 + wq * 2 + 1] = d2; }
    }
    __syncthreads();
    if (T.last) {
        float* dst = L.out + (T.samp ? O_NBS + (size_t)(L.l * 32 + T.b) * 30 * 256 : O_NBP + (size_t)(L.l * 4 + T.b) * 30 * 256);
        for (int i = tid; i < 30 * 256; i += 512) dst[i] = G[64 * 256 + i];
    }
    if (tid < 64) {
        const f32x4 ra = *(LAS f32x4*)(red + tid * 8), rb = *(LAS f32x4*)(red + tid * 8 + 4);
        const float S1 = (ra.x + ra.z) + (rb.x + rb.z), S2 = (ra.y + ra.w) + (rb.y + rb.w);
        const float mu = S1 * (1.f / 256.f), var = S2 * (1.f / 256.f) - mu * mu;
        stat[tid * 2] = mu; stat[tid * 2 + 1] = rsqrtf(fmaxf(var, 0.f) + EPS);
    }
    const float lg = L.lng[c], lb = L.lnb[c];
    __syncthreads();
    {
        typedef float f32x2v __attribute__((ext_vector_type(2)));
        f32x2v st[4][8]; float gt[4][8];
#pragma unroll
        for (int ch = 0; ch < 4; ++ch)
#pragma unroll
            for (int j = 0; j < 8; ++j) { const int t = th * 32 + ch * 8 + j; st[ch][j] = *(const LAS f32x2v*)(stat + t * 2); gt[ch][j] = bf1(SB[t * 256 + c]); }
#pragma unroll
        for (int ch = 0; ch < 4; ++ch)
#pragma unroll
            for (int j = 0; j < 8; ++j) {
                const float zn = (z[ch][j] - st[ch][j].x) * (st[ch][j].y * lg) + lb;
                gt[ch][j] = silu(zn) * gt[ch][j];
            }
#pragma unroll
        for (int ch = 0; ch < 4; ++ch)
#pragma unroll
            for (int j = 0; j < 8; ++j) { const int t = th * 32 + ch * 8 + j; SB[t * 256 + c] = (bf16)(cvtpk(gt[ch][j], 0.f) & 0xffffu); }
    }
    __syncthreads();
#pragma unroll
    for (int k = 0; k < 4; ++k) { const int i = tid + 512 * k, r = i >> 5, c0 = (i & 31) * 8; *(v4u*)(L.Y + (size_t)(T.row0 + r) * D + 256 + c0) = *(LAS v4u*)(SB + i * 8); }
    __syncthreads();
}

__device__ __forceinline__ void mix_c(const Lay& L, const Tile& T, int tid, LAS unsigned char* lds) {
    asm volatile("" : "+v"(tid));
    LAS float* P = (LAS float*)lds;
    LAS bf16* Dm = (LAS bf16*)(lds + 81920);
    const int wave = tid >> 6, lane = tid & 63, mg = wave & 3, mth = wave >> 2, mr = lane & 15, mq = lane >> 4;
    v2u cg2[4][2];
    bf16x8 af[4][2];
    {
        v4u rg[5];
#pragma unroll
        for (int k = 0; k < 5; ++k) {
            const int i = tid + 512 * k, r = i >> 5, c0 = (i & 31) * 8, tt = r - 15;
            rg[k] = (i < 79 * 32 && (tt >= 0 || !T.first)) ? __builtin_nontemporal_load((const v4u*)(L.U + (size_t)(T.row0 + tt) * UC + C_CU + c0)) : (v4u){0u, 0u, 0u, 0u};
        }
#pragma unroll
        for (int mt = 0; mt < 4; ++mt)
#pragma unroll
            for (int nt = 0; nt < 2; ++nt) cg2[mt][nt] = *(const v2u*)(L.U + (size_t)(T.row0 + mth * 32 + nt * 16 + mr) * UC + C_SCG + mg * 64 + mt * 16 + 4 * mq);
#pragma unroll
        for (int mt = 0; mt < 4; ++mt)
#pragma unroll
            for (int kk = 0; kk < 2; ++kk) af[mt][kk] = *(const bf16x8*)(L.PWT + ((size_t)(mg * 64 + mt * 16 + mr)) * 64 + kk * 32 + mq * 8);
#pragma unroll
        for (int k = 0; k < 5; ++k) {
            const int i = tid + 512 * k, r = i >> 5, c0 = (i & 31) * 8, tt = r - 15;
            if (i < 79 * 32) {
                float g8[8]; unpack8(rg[k], g8);
                if (tt < 0 && T.first && T.samp) ld8f(L.stp + ((size_t)T.b * 15 + r) * 256 + c0, g8);
                *(LAS f32x4*)(P + r * 256 + c0) = (f32x4){g8[0], g8[1], g8[2], g8[3]};
                *(LAS f32x4*)(P + r * 256 + c0 + 4) = (f32x4){g8[4], g8[5], g8[6], g8[7]};
            }
        }
    }
    __syncthreads();
    {
        const int c = tid & 255, th = tid >> 8, g = __builtin_amdgcn_readfirstlane(c >> 6), w = 2 << g;
        const LAS float* Pc = P + th * 32 * 256 + c;
        float x[47], cur[32];
#pragma unroll
        for (int i = 0; i < 47; ++i) x[i] = Pc[i * 256];
#pragma unroll
        for (int i = 0; i < 32; ++i) cur[i] = x[15 + i];
#pragma unroll
        for (int i = 46; i >= 1; --i) x[i] += x[i - 1];
        if (g >= 1) {
#pragma unroll
            for (int i = 46; i >= 3; --i) x[i] += x[i - 2];
        }
        if (g >= 2) {
#pragma unroll
            for (int i = 46; i >= 7; --i) x[i] += x[i - 4];
        }
        if (g >= 3) {
#pragma unroll
            for (int i = 46; i >= 15; --i) x[i] += x[i - 8];
        }
        const int pos1 = (T.samp ? 1024 : 0) + T.t0 + th * 32 + 1;
        const float rw = __builtin_amdgcn_rcpf((float)w);
#pragma unroll
        for (int i = 0; i < 32; ++i) {
            const float rc = (pos1 + i >= w) ? rw : __builtin_amdgcn_rcpf((float)(pos1 + i));
            const float d = x[15 + i] * rc - cur[i];
            Dm[(th * 32 + i) * 264 + c] = (bf16)(cvtpk(d, 0.f) & 0xffffu);
        }
    }
    __syncthreads();
    if (T.last) {
        float* dst = L.out + (T.samp ? O_NPS + (size_t)(L.l * 32 + T.b) * 15 * 256 : O_NPP + (size_t)(L.l * 4 + T.b) * 15 * 256);
        for (int i = tid; i < 15 * 256; i += 512) dst[i] = P[64 * 256 + i];
    }
    {
        bf16x8 bfr[2][2];
#pragma unroll
        for (int nt = 0; nt < 2; ++nt)
#pragma unroll
            for (int kk = 0; kk < 2; ++kk) bfr[nt][kk] = *(const LAS bf16x8*)(Dm + (mth * 32 + nt * 16 + mr) * 264 + mg * 64 + kk * 32 + mq * 8);
        f32x4 acc[4][2];
#pragma unroll
        for (int mt = 0; mt < 4; ++mt)
#pragma unroll
            for (int nt = 0; nt < 2; ++nt) {
                f32x4 a = (f32x4){0.f, 0.f, 0.f, 0.f};
                a = __builtin_amdgcn_mfma_f32_16x16x32_bf16(af[mt][0], bfr[nt][0], a, 0, 0, 0);
                a = __builtin_amdgcn_mfma_f32_16x16x32_bf16(af[mt][1], bfr[nt][1], a, 0, 0, 0);
                acc[mt][nt] = a;
            }
#pragma unroll
        for (int mt = 0; mt < 4; ++mt) {
            const int chn = mg * 64 + mt * 16 + 4 * mq;
            const f32x4 pb = *(const f32x4*)(L.pbias + chn), ps = *(const f32x4*)(L.pscale + chn);
#pragma unroll
            for (int nt = 0; nt < 2; ++nt) {
                const size_t row = (size_t)(T.row0 + mth * 32 + nt * 16 + mr);
                const float y0 = (acc[mt][nt][0] + pb.x) * ps.x * bflo(cg2[mt][nt].x), y1 = (acc[mt][nt][1] + pb.y) * ps.y * bfhi(cg2[mt][nt].x);
                const float y2 = (acc[mt][nt][2] + pb.z) * ps.z * bflo(cg2[mt][nt].y), y3 = (acc[mt][nt][3] + pb.w) * ps.w * bfhi(cg2[mt][nt].y);
                v2u o; o.x = cvtpk(y0, y1); o.y = cvtpk(y2, y3);
                *(v2u*)(L.Y + row * D + 512 + chn) = o;
            }
        }
    }
    __syncthreads();
}

__device__ __forceinline__ void mix_x(const Lay& L, const Tile& T, int hp, int tid, LAS unsigned char* lds) {
    asm volatile("" : "+v"(tid));
    const int wave = __builtin_amdgcn_readfirstlane(tid >> 6), lane = tid & 63, hl = wave >> 2, h = hp * 2 + hl, nt = wave & 3, r = lane & 15, q = lane >> 4;
    {
        const char* ksrc = (const char*)(L.KB + ((size_t)T.seq * 4 + hp * 2) * 16384);
        const char* vsrc = (const char*)(L.VT + ((size_t)T.seq * 4 + hp * 2) * 16384);
#pragma unroll
        for (int i = 0; i < 8; ++i) {
            const int cb = i * 8 + wave;
            const int dst = (cb >> 5) * 65536 + (cb & 31) * 1024;
            __builtin_amdgcn_global_load_lds((const unsigned*)(ksrc + (size_t)cb * 1024 + lane * 16), (LAS unsigned*)(lds + dst), 16, 0, 0);
            __builtin_amdgcn_global_load_lds((const unsigned*)(vsrc + (size_t)cb * 1024 + lane * 16), (LAS unsigned*)(lds + dst + 32768), 16, 0, 0);
        }
    }
    const size_t row = (size_t)(T.row0 + nt * 16 + r);
    bf16x8 qf[2];
#pragma unroll
    for (int kk = 0; kk < 2; ++kk) qf[kk] = *(const bf16x8*)(L.U + row * UC + C_Q + h * 64 + kk * 32 + q * 8);
    v2u xg[4];
#pragma unroll
    for (int dt = 0; dt < 4; ++dt) xg[dt] = *(const v2u*)(L.U + row * UC + C_SXG + h * 64 + dt * 16 + 4 * q);
    asm volatile("s_waitcnt vmcnt(0)" ::: "memory");
    __syncthreads();
    const LAS bf16x8* Kf = (const LAS bf16x8*)(lds + hl * 65536) + lane;
    const LAS bf16x8* Vf = (const LAS bf16x8*)(lds + hl * 65536 + 32768) + lane;
    f32x4 s[16];
#pragma unroll
    for (int mt = 0; mt < 16; ++mt) {
        const bf16x8 k0 = Kf[(mt * 2) * 64], k1 = Kf[(mt * 2 + 1) * 64];
        f32x4 a = (f32x4){0.f, 0.f, 0.f, 0.f};
        a = __builtin_amdgcn_mfma_f32_16x16x32_bf16(k0, qf[0], a, 0, 0, 0);
        a = __builtin_amdgcn_mfma_f32_16x16x32_bf16(k1, qf[1], a, 0, 0, 0);
        s[mt] = a;
    }
    float mx = -3.0e38f;
#pragma unroll
    for (int mt = 0; mt < 16; ++mt) mx = fmaxf(mx, fmaxf(fmaxf(s[mt][0], s[mt][1]), fmaxf(s[mt][2], s[mt][3])));
    mx = fmaxf(mx, __shfl_xor(mx, 16)); mx = fmaxf(mx, __shfl_xor(mx, 32));
    float sum = 0.f;
#pragma unroll
    for (int mt = 0; mt < 16; ++mt)
#pragma unroll
        for (int j = 0; j < 4; ++j) { const float pv = __builtin_amdgcn_exp2f(s[mt][j] - mx); s[mt][j] = pv; sum += pv; }
    sum += __shfl_xor(sum, 16); sum += __shfl_xor(sum, 32);
    const float inv = 1.0f / sum;
    f32x4 o[4];
#pragma unroll
    for (int dt = 0; dt < 4; ++dt) o[dt] = (f32x4){0.f, 0.f, 0.f, 0.f};
#pragma unroll
    for (int mp = 0; mp < 8; ++mp) {
        v4u pk; pk.x = cvtpk(s[2 * mp][0], s[2 * mp][1]); pk.y = cvtpk(s[2 * mp][2], s[2 * mp][3]);
        pk.z = cvtpk(s[2 * mp + 1][0], s[2 * mp + 1][1]); pk.w = cvtpk(s[2 * mp + 1][2], s[2 * mp + 1][3]);
        const bf16x8 pf = __builtin_bit_cast(bf16x8, pk);
#pragma unroll
        for (int dt = 0; dt < 4; ++dt) o[dt] = __builtin_amdgcn_mfma_f32_16x16x32_bf16(Vf[(mp * 4 + dt) * 64], pf, o[dt], 0, 0, 0);
    }
#pragma unroll
    for (int dt = 0; dt < 4; ++dt) {
        const float y0 = o[dt][0] * inv * bflo(xg[dt].x), y1 = o[dt][1] * inv * bfhi(xg[dt].x);
        const float y2 = o[dt][2] * inv * bflo(xg[dt].y), y3 = o[dt][3] * inv * bfhi(xg[dt].y);
        v2u ov; ov.x = cvtpk(y0, y1); ov.y = cvtpk(y2, y3);
        *(v2u*)(L.Y + row * D + 768 + h * 64 + dt * 16 + 4 * q) = ov;
    }
    __syncthreads();
}

#define XB_TMO      128
#define XB_XCNT(j)  (256  + 64 * (j))
#define XB_XSUB(j)  (1280 + 64 * (j))
#define XB_XGEN(j)  (2304 + 64 * (j))
#define XB_TOP      3328
#define XB_TOPGEN   3392
#define XCD_BAR_WORDS 3456
#define XB_SPIN_CAP (1u << 18)

__device__ __forceinline__ unsigned xb_ld(unsigned* p)              { return __hip_atomic_load(p, __ATOMIC_RELAXED, __HIP_MEMORY_SCOPE_AGENT); }
__device__ __forceinline__ unsigned xb_add(unsigned* p, unsigned v) { return __hip_atomic_fetch_add(p, v, __ATOMIC_RELAXED, __HIP_MEMORY_SCOPE_AGENT); }
__device__ __forceinline__ unsigned xb_xcc_id() { return (unsigned)__builtin_amdgcn_s_getreg((3 << 11) | 20) & 0xFu; }
#define XB_SPIN(cond, bar) do { unsigned _sp = 0; while (cond) { __builtin_amdgcn_s_sleep(1); \
    if ((++_sp & 255u) == 0u) { if (xb_ld(&(bar)[XB_TMO])) break; if (_sp > XB_SPIN_CAP) { atomicAdd(&(bar)[XB_TMO], 1u); break; } } } } while (0)

struct XcdBarrier {
    unsigned* bar; unsigned x;
    volatile LAS unsigned* st;
};

__device__ __forceinline__ XcdBarrier xcd_barrier_post(unsigned* bar, volatile LAS unsigned* st) {
    XcdBarrier b; b.bar = bar; b.x = xb_xcc_id(); b.st = st;
    if (threadIdx.x == 0) (void)xb_add(&bar[XB_XCNT(b.x)], 1u);
    return b;
}
__device__ __forceinline__ void xcd_barrier_complete(unsigned* bar, unsigned x, unsigned& nloc, unsigned& nx) {
    const unsigned G = gridDim.x * gridDim.y * gridDim.z;
    unsigned sum, cnt, mine, sp = 0u;
    for (;;) {
        sum = 0u; cnt = 0u; mine = 0u;
#pragma unroll
        for (unsigned j = 0; j < 16; ++j) { const unsigned c = xb_ld(&bar[XB_XCNT(j)]); sum += c; cnt += (c > 0u) ? 1u : 0u; mine = (j == x) ? c : mine; }
        if (sum == G) break;
        __builtin_amdgcn_s_sleep(1);
        if ((++sp & 255u) == 0u) { if (xb_ld(&bar[XB_TMO])) break; if (sp > XB_SPIN_CAP) { atomicAdd(&bar[XB_TMO], 1u); break; } }
    }
    nloc = mine > 0u ? mine : 1u; nx = cnt > 0u ? cnt : 1u;
}

__device__ __forceinline__ void xcd_barrier(const XcdBarrier& b) {
    asm volatile("s_waitcnt vmcnt(0)" ::: "memory");
    __syncthreads();
    if (threadIdx.x == 0) {
        unsigned* bar = b.bar;
        __builtin_amdgcn_s_waitcnt(0);
        unsigned nloc = b.st[0], nx = b.st[1];
        if (nloc == 0u) { xcd_barrier_complete(bar, b.x, nloc, nx); b.st[0] = nloc; b.st[1] = nx; }
        const unsigned old = xb_add(&bar[XB_XSUB(b.x)], 1u);
        const unsigned gen = old / nloc;
        if (old + 1u == (gen + 1u) * nloc) {
            __builtin_amdgcn_fence(__ATOMIC_RELEASE, "agent");
            asm volatile("s_waitcnt vmcnt(0)" ::: "memory");
            const unsigned og = xb_add(&bar[XB_TOP], 1u);
            const unsigned tg = og / nx;
            if (og + 1u == (tg + 1u) * nx) xb_add(&bar[XB_TOPGEN], 1u);
            else XB_SPIN(xb_ld(&bar[XB_TOPGEN]) == tg, bar);
            __builtin_amdgcn_fence(__ATOMIC_ACQUIRE, "agent");
            xb_add(&bar[XB_XGEN(b.x)], 1u);
            asm volatile("s_waitcnt vmcnt(0)" ::: "memory");
        } else {
            XB_SPIN(xb_ld(&bar[XB_XGEN(b.x)]) == gen, bar);
            __builtin_amdgcn_fence(__ATOMIC_ACQUIRE, "agent");
            asm volatile("s_waitcnt vmcnt(0)" ::: "memory");
        }
    }
    __syncthreads();
}

#define WIN ((bf16*)(ws + WS_WIN))
#define WOUT ((bf16*)(ws + WS_WOUT))
#define WMEM ((bf16*)(ws + WS_WMEM))
#define W_PWT ((bf16*)(ws + WS_PWT))
#define RSM ((float*)(ws + WS_RSM))
#define SSPA ((float*)(ws + WS_SSPA))
#define SSPB ((float*)(ws + WS_SSPB))
#define MNB ((bf16*)(ws + WS_MNB))
#define W_KB ((bf16*)(ws + WS_KB))
#define W_VT ((bf16*)(ws + WS_VT))
#define XB ((bf16*)(ws + WS_XB))
#define YB ((bf16*)(ws + WS_Y))
#define UB ((bf16*)(ws + WS_U))
#define PHASE_WS __attribute__((address_space(1))) unsigned char* wsg_ = (__attribute__((address_space(1))) unsigned char*)p.ws; asm volatile("" : "+s"(wsg_)); unsigned char* ws = (unsigned char*)wsg_;
__global__ void __launch_bounds__(512, 2) hymba_fwd(Params p) {
    extern __shared__ __attribute__((aligned(16))) unsigned char lds_raw[];
    LAS unsigned char* lds = (LAS unsigned char*)lds_raw;
    cg::grid_group grid = cg::this_grid();
    const int tid = threadIdx.x, lane = tid & 63, wave = __builtin_amdgcn_readfirstlane(tid >> 6);
    const int G = gridDim.x, bx = blockIdx.x;
    if (tid < 2) ((LAS unsigned*)(lds + 133120))[tid] = 0u;
    __syncthreads();
    const XcdBarrier bar = xcd_barrier_post((unsigned*)(p.ws + WS_CTL), (volatile LAS unsigned*)(lds + 133120));
    if (tid == 0) ((LAS unsigned*)(lds + 134144))[0] = __hip_atomic_fetch_add((unsigned*)(p.ws + WS_CTL) + 3520 + bar.x, 1u, __ATOMIC_RELAXED, __HIP_MEMORY_SCOPE_AGENT);

    {
        PHASE_WS
        const float* xp = p.in[0]; const float* xs = p.in[1];
        LAS float* scr = (LAS float*)(lds + wave * 16384);
        const int gw = bx * 8 + wave, NGW = G * 8;
        constexpr int I_IN = 16 * 88, I_OUT = 16 * 32, I_MEM = 16 * 8, I_L = I_IN + I_OUT + 2 * I_MEM;
        for (int it = gw; it < 2 * I_L; it += NGW) {
            const int l = it / I_L; int r = it % I_L;
            if (r < I_IN) { transpose_item(p.in[9] + (size_t)l * D * NC, D, NC, WIN + (size_t)l * NC * D, 0, p.in[8] + l * D, scr, r, lane, true); continue; } r -= I_IN;
            if (r < I_OUT) { transpose_item(p.in[21] + (size_t)l * D * D, D, D, WOUT + (size_t)l * D * D, 0, nullptr, scr, r, lane); continue; } r -= I_OUT;
            if (r < I_MEM) { transpose_item(p.in[19] + (size_t)l * D * 256, D, 256, WMEM, l * 512, p.in[18] + l * D, scr, r, lane); continue; } r -= I_MEM;
            transpose_item(p.in[20] + (size_t)l * D * 256, D, 256, WMEM, l * 512 + 256, p.in[18] + l * D, scr, r, lane);
        }
        for (int m0 = gw; m0 < M; m0 += 4 * NGW) {
            f32x4 v[4][4]; float ss[4];
#pragma unroll
            for (int u = 0; u < 4; ++u) {
                const int m = m0 + u * NGW;
                const float* xr = m < NPR ? xp + (size_t)m * D : xs + (size_t)(m - NPR) * D;
#pragma unroll
                for (int j = 0; j < 4; ++j) v[u][j] = (m < M) ? __builtin_nontemporal_load((const f32x4*)xr + lane + 64 * j) : (f32x4){0.f, 0.f, 0.f, 0.f};
            }
#pragma unroll
            for (int u = 0; u < 4; ++u) {
                float a = 0.f;
#pragma unroll
                for (int j = 0; j < 4; ++j) a += (v[u][j].x * v[u][j].x + v[u][j].y * v[u][j].y) + (v[u][j].z * v[u][j].z + v[u][j].w * v[u][j].w);
                ss[u] = wave_sum(a);
            }
#pragma unroll
            for (int u = 0; u < 4; ++u) {
                const int m = m0 + u * NGW;
                if (m < M) {
                    v2u* o8 = (v2u*)(XB + (size_t)m * D) + lane;
#pragma unroll
                    for (int j = 0; j < 4; ++j) { v2u w; w.x = cvtpk(v[u][j].x, v[u][j].y); w.y = cvtpk(v[u][j].z, v[u][j].w); o8[64 * j] = w; }
                    if (lane < 16) SSPA[(size_t)m * 16 + lane] = (lane == 0) ? ss[u] : 0.f;
                }
            }
        }
        for (int m = gw; m < 1024; m += NGW) {
            const float ss = row_to_bf16(p.in[2] + (size_t)m * D, MNB + (size_t)m * D, lane);
            if (lane == 0) RSM[m] = rsqrtf(ss * (1.f / 1024.f) + EPS);
        }
        for (int i8 = bx * 512 + tid; i8 < 2 * 32 * 65536 / 8; i8 += G * 512) {
            const size_t i = (size_t)i8 * 8; const int l = (int)(i >> 21), b = (int)((i >> 16) & 31), mem = (int)((i >> 8) & 255), h = (int)((i >> 6) & 3), d = (int)(i & 63);
            const f32x4 a = *(const f32x4*)(p.in[6] + i), c = *(const f32x4*)(p.in[6] + i + 4);
            v4u o; o.x = cvtpk(a.x, a.y); o.y = cvtpk(a.z, a.w); o.z = cvtpk(c.x, c.y); o.w = cvtpk(c.z, c.w);
            const int mt = (mem >> 5) * 2 + ((mem >> 2) & 1), r = ((mem >> 3) & 3) * 4 + (mem & 3), kk = d >> 5, q = (d >> 3) & 3;
            *(v4u*)(W_KB + ((size_t)((l * NSEQ + 4 + b) * 4 + h) * 32 + mt * 2 + kk) * 512 + (q * 16 + r) * 8) = o;
        }
        for (int it = gw; it < 8192; it += NGW) {
            const int mg = it & 31, h = (it >> 5) & 3, b = (it >> 7) & 31, l = it >> 12;
            float f[8];
#pragma unroll
            for (int i = 0; i < 8; ++i) f[i] = p.in[7][(((size_t)(l * 32 + b) * 256 + mg * 8 + i) * 4 + h) * 64 + lane];
            const int mp = mg >> 2, q = mg & 3, dt = lane >> 4, r = lane & 15;
            *(v4u*)(W_VT + ((size_t)((l * NSEQ + 4 + b) * 4 + h) * 32 + mp * 4 + dt) * 512 + (q * 16 + r) * 8) = pack8(f);
        }
        for (int i = bx * 512 + tid; i < 32768; i += G * 512) {
            const int c = i & 63, e = (i >> 6) & 63, lg = i >> 12;
            W_PWT[i] = (bf16)(cvtpk(p.in[15][((size_t)lg * 64 + c) * 64 + e], 0.f) & 0xffffu);
        }
    }
    grid.sync();
    int vb;
    {
        const unsigned* cen = (const unsigned*)(p.ws + WS_CTL) + 3520;
        bool uni = (G % 8) == 0;
#pragma unroll
        for (int j = 0; j < 16; ++j) { const unsigned cj = __hip_atomic_load(cen + j, __ATOMIC_RELAXED, __HIP_MEMORY_SCOPE_AGENT); uni = uni && (cj == (j < 8 ? (unsigned)(G >> 3) : 0u)); }
        const int rank = (int)((volatile LAS unsigned*)(lds + 134144))[0];
        vb = __builtin_amdgcn_readfirstlane(uni ? (int)bar.x + 8 * rank : bx);
    }

    {
        PHASE_WS
        pg8::Gemm g{MNB, WMEM, 1024, 1024, D}; pg8::StaticOrder S; S.init(1024, 1024, G, G - 1 - vb);
        EpiKV E{RSM, p.out, W_KB, W_VT};
        pg8::gemm_phase<EpiKV, pg8::StaticOrder, false, true>(lds, g, S, E);
    }

    for (int l = 0; l < 2; ++l) {
        {
            PHASE_WS
            pg8::Gemm g{XB, WIN + (size_t)l * NC * D, M, NC, D}; pg8::StaticOrder S; S.init(M, NC, G, vb);
            EpiU E{UB, l == 0 ? SSPA : SSPB};
            pg8::gemm_phase<EpiU, pg8::StaticOrder, true, true>(lds, g, S, E);
        }
        xcd_barrier(bar);
        {
            PHASE_WS
            Lay L;
            L.U = UB; L.Y = YB; L.KB = W_KB + (size_t)l * NSEQ * 65536; L.VT = W_VT + (size_t)l * NSEQ * 65536; L.PWT = W_PWT + (size_t)l * 16384;
            L.caw = p.in[10] + l * 768; L.cbw = p.in[11] + l * 31 * 256; L.cbb = p.in[12] + l * 256; L.lng = p.in[13] + l * 256; L.lnb = p.in[14] + l * 256;
            L.pbias = p.in[16] + l * 256; L.pscale = p.in[17] + l * 256;
            L.sta = p.in[3] + (size_t)l * 32 * 2 * 256; L.stb = p.in[4] + (size_t)l * 32 * 30 * 256; L.stp = p.in[5] + (size_t)l * 32 * 15 * 256;
            L.out = p.out; L.l = l;
            const int nk = (5 * NTILE - vb + G - 1) / G;
            for (int kk = 0; kk < nk; ++kk) {
                int k2 = kk + (vb >> 3) % nk; if (k2 >= nk) k2 -= nk;
                const int idx = vb + k2 * G;
                const int grp = idx / NTILE; const Tile T = mk_tile(idx % NTILE); const int hp = grp - 2;
                if (grp == 0) mix_b(L, T, tid, lds);
                else if (grp == 1) mix_c(L, T, tid, lds);
                else if (grp < 4) mix_x(L, T, hp, tid, lds);
                else mix_a(L, T, tid);
            }
        }
        xcd_barrier(bar);
        {
            PHASE_WS
            pg8::Gemm g{YB, WOUT + (size_t)l * D * D, M, D, D}; pg8::StaticOrder S; S.init(M, D, G, vb);
            EpiX E{XB, l == 0 ? SSPB : SSPA, XB};
            pg8::gemm_phase<EpiX, pg8::StaticOrder, true, true>(lds, g, S, E);
        }
        xcd_barrier(bar);
    }
    {
        PHASE_WS
        const int gw = bx * 8 + wave, NGW = G * 8;
        const float* gf = p.in[22];
        f32x4 gv[4];
#pragma unroll
        for (int j = 0; j < 4; ++j) gv[j] = ((const f32x4*)gf)[lane + 64 * j];
        for (int m = gw; m < M; m += NGW) {
            const f32x4* sp = (const f32x4*)(SSPA + (size_t)m * 16);
            const f32x4 s0 = sp[0], s1 = sp[1], s2 = sp[2], s3 = sp[3];
            const float ss = ((s0.x + s0.y) + (s0.z + s0.w)) + ((s1.x + s1.y) + (s1.z + s1.w)) + ((s2.x + s2.y) + (s2.z + s2.w)) + ((s3.x + s3.y) + (s3.z + s3.w));
            const float rstd = rsqrtf(ss * (1.f / 1024.f) + EPS);
            const v2u* xr = (const v2u*)(XB + (size_t)m * D) + lane;
            f32x4* yr = (f32x4*)(p.out + (size_t)m * D) + lane;
            v2u xv[4];
#pragma unroll
            for (int j = 0; j < 4; ++j) xv[j] = __builtin_nontemporal_load(xr + 64 * j);
#pragma unroll
            for (int j = 0; j < 4; ++j) { const f32x4 v = (f32x4){bflo(xv[j].x), bfhi(xv[j].x), bflo(xv[j].y), bfhi(xv[j].y)}; __builtin_nontemporal_store(v * rstd * gv[j], yr + 64 * j); }
        }
    }
}

extern "C" void kernel_launch(void* const* d_in, const int* in_sizes, int n_in, void* d_out, int out_size, void* d_ws, size_t ws_size, hipStream_t stream) {
    static int grid_blocks = 0;
    if (grid_blocks == 0) {
        if (n_in != 23 || (size_t)out_size != O_END || ws_size < WS_END) { fprintf(stderr, "kernel_launch: unexpected shapes (n_in %d out %d ws %zu)\n", n_in, out_size, ws_size); grid_blocks = -1; return; }
        int dev = 0, cus = 0, per_cu = 0;
        hipGetDevice(&dev);
        hipDeviceGetAttribute(&cus, hipDeviceAttributeMultiprocessorCount, dev);
        if (hipFuncSetAttribute((const void*)hymba_fwd, hipFuncAttributeMaxDynamicSharedMemorySize, LDS_BYTES) != hipSuccess) { fprintf(stderr, "kernel_launch: hipFuncSetAttribute failed\n"); grid_blocks = -1; return; }
        if (hipOccupancyMaxActiveBlocksPerMultiprocessor(&per_cu, (const void*)hymba_fwd, 512, LDS_BYTES) != hipSuccess || per_cu < 1) { fprintf(stderr, "kernel_launch: occupancy query says %d\n", per_cu); per_cu = 1; }
        (void)hipGetLastError();
        grid_blocks = cus * 1;
    }
    if (grid_blocks < 0) return;
    Params p{};
    for (int i = 0; i < 23; ++i) p.in[i] = (const float*)d_in[i];
    p.out = (float*)d_out; p.ws = (unsigned char*)d_ws;
    if (hipMemsetAsync((char*)d_ws + WS_CTL, 0, 16384, stream) != hipSuccess) { fprintf(stderr, "kernel_launch: memset of barrier words failed\n"); return; }
    void* args[] = {&p};
    hipError_t e = hipLaunchCooperativeKernel((const void*)hymba_fwd, dim3(grid_blocks), dim3(512), args, LDS_BYTES, stream);
    if (e != hipSuccess) fprintf(stderr, "cooperative launch failed: %s (grid %d)\n", hipGetErrorString(e), grid_blocks);
}
```

```cpp
#include <hip/hip_runtime.h>
#include <hip/hip_cooperative_groups.h>
#include <cstdio>
#include <cstdint>
namespace cg = cooperative_groups;
namespace pg8 {
#define PG8_LAS __attribute__((address_space(3)))
typedef unsigned short bf16_t;
typedef short bf16x8 __attribute__((ext_vector_type(8)));
typedef float f32x4 __attribute__((ext_vector_type(4)));
typedef unsigned u32x4 __attribute__((ext_vector_type(4)));
constexpr int BM = 256, BK = 64, HALF = 128, HTB = HALF * BK * 2  , STAGE_BYTES = 8 * HTB, NXCD = 8, WGM = 8;

__host__ __device__ __forceinline__ int lds_byte(int r, int c) { const int st = (r >> 4) * 2 + (c >> 5), rr = r & 15, cc = c & 31, ob = rr * 64 + cc * 2; return st * 1024 + (ob ^ (((ob >> 9) & 1) << 5)); }
__host__ __device__ __forceinline__ void stage_rc(int b, int& R, int& C) { const int st = b / 1024, sb = b % 1024, swz = sb ^ (((sb >> 9) & 1) << 5); R = (st >> 1) * 16 + swz / 64; C = (st & 1) * 32 + (swz % 64) / 2; }
__host__ __device__ __forceinline__ int perm32(int rho) { const int n = rho >> 4, i = rho & 15; return 8 * (i >> 2) + 4 * n + (i & 3); }

struct Unit { int pm, pn; };
struct Gemm { const bf16_t* A; const bf16_t* Bt; int M, N, K; };

struct StaticOrder {
    int nM, nN, nwg, G, c;
    __host__ __device__ void init(int M, int N, int G_, int c_) { nM = M / BM; nN = N / BM; nwg = nM * nN; G = G_; c = c_; }
    __host__ __device__ bool next(int i, Unit& u) const {
        const long L = (long)i * G + c; if (L >= nwg) return false;
        int wgid = (int)L; { const int q = nwg / NXCD, r = nwg % NXCD, xcd = wgid % NXCD, off = wgid / NXCD; wgid = (xcd < r ? xcd * (q + 1) : r * (q + 1) + (xcd - r) * q) + off; }
        const int nig = WGM * nN, gid = wgid / nig, fm = gid * WGM, gsz = (nM - fm) < WGM ? (nM - fm) : WGM;
        u.pm = fm + ((wgid % nig) % gsz); u.pn = (wgid % nig) / gsz; return true;
    }
    __device__ __forceinline__ void a_ready(const Unit&) const {}
    __device__ __forceinline__ void done(const Unit&) const {}
};
__device__ __forceinline__ unsigned cvt_pk_bf16(float lo, float hi) { unsigned r; asm volatile("v_cvt_pk_bf16_f32 %0, %1, %2" : "=v"(r) : "v"(lo), "v"(hi)); return r; }
template <class Epi, class Sched, bool ALIGN_EPI = false, bool SP2 = false>
__device__ __forceinline__ void gemm_phase(PG8_LAS unsigned char* lds, const Gemm g, const Sched& S, const Epi& E) {
    const int tid = threadIdx.x, wid = __builtin_amdgcn_readfirstlane(tid >> 6), lane = tid & 63, wr = wid >> 2, wc = wid & 3, fr = lane & 15, fq = lane >> 4;
    const int K = g.K, nt = K / BK;
    unsigned voffA[2], voffB[2];
#pragma unroll
    for (int i = 0; i < 2; ++i) { int R, C; stage_rc(tid * 16 + i * 8192, R, C); const int Rb = Epi::PERM ? ((R & ~31) + perm32(R & 31)) : R;
        voffA[i] = (unsigned)(R * K + C) * 2u; voffB[i] = (unsigned)(Rb * K + C) * 2u; }
    const size_t kstep = (size_t)(BK * 2);
    const size_t hstep = (size_t)HALF * K * 2;
    const size_t tstep = 2 * hstep;
    const unsigned ldsw = (unsigned)wid * 1024u;
    const int aoff = lds_byte(wr * 64 + fr, fq * 8), boff = lds_byte(wc * 32 + fr, fq * 8);
#define PG8_SA(b, h) (((b) * 2 + (h)) * HTB)
#define PG8_SB(b, h) ((4 + (b) * 2 + (h)) * HTB)
#define PG8_STAGE(bufoff, gbase, voff) do { _Pragma("unroll") for (int _i = 0; _i < 2; ++_i) \
        __builtin_amdgcn_global_load_lds((const unsigned*)((const char*)(gbase) + (voff)[_i]), (PG8_LAS unsigned*)(lds + (bufoff) + ldsw + _i * 8192), 16, 0, 0); } while (0)
#define PG8_LDA(dst, b, h) do { _Pragma("unroll") for (int m = 0; m < 4; ++m) _Pragma("unroll") for (int k = 0; k < 2; ++k) dst[m][k] = *(const PG8_LAS bf16x8*)(lds + PG8_SA(b, h) + aoff + m * 2048 + k * 1024); } while (0)
#define PG8_LDB(dst, b, h) do { _Pragma("unroll") for (int n = 0; n < 2; ++n) _Pragma("unroll") for (int k = 0; k < 2; ++k) dst[n][k] = *(const PG8_LAS bf16x8*)(lds + PG8_SB(b, h) + boff + n * 2048 + k * 1024); } while (0)
#define PG8_MMA(ai, bj, At, Bt) do { __builtin_amdgcn_s_setprio(1); _Pragma("unroll") for (int m = 0; m < 4; ++m) _Pragma("unroll") for (int n = 0; n < 2; ++n) _Pragma("unroll") for (int k = 0; k < 2; ++k) \
        acc[ai][bj][m][n] = __builtin_amdgcn_mfma_f32_16x16x32_bf16(Bt[n][k], At[m][k], acc[ai][bj][m][n], 0, 0, 0); __builtin_amdgcn_s_setprio(0); } while (0)
#define PG8_WAIT_V(n) asm volatile("s_waitcnt vmcnt(" #n ")" ::: "memory")
#define PG8_WAIT_L(n) asm volatile("s_waitcnt lgkmcnt(" #n ")" ::: "memory")
#define PG8_BAR __builtin_amdgcn_s_barrier()
#define PG8_SCHED __builtin_amdgcn_sched_barrier(0)
    Unit cur, nxt; int ui = 0;
    if (!S.next(0, cur)) return;
    f32x4 acc[2][2][4][2];
#pragma unroll
    for (int a = 0; a < 2; ++a)
#pragma unroll
        for (int b = 0; b < 2; ++b)
#pragma unroll
            for (int m = 0; m < 4; ++m)
#pragma unroll
                for (int n = 0; n < 2; ++n) acc[a][b][m][n] = (f32x4){0.f, 0.f, 0.f, 0.f};
    bf16x8 At[4][2], B0[2][2], B1[2][2];
    const char* cA = (const char*)g.A + (size_t)cur.pm * tstep; const char* cB = (const char*)g.Bt + (size_t)cur.pn * tstep;
    S.a_ready(cur);
    if constexpr (SP2) {
        PG8_STAGE(PG8_SB(0, 0), cB, voffB); PG8_STAGE(PG8_SB(0, 1), cB + hstep, voffB); PG8_STAGE(PG8_SA(0, 0), cA, voffA); PG8_STAGE(PG8_SA(0, 1), cA + hstep, voffA);
        if (wr == 1) PG8_BAR;
        PG8_WAIT_V(2); PG8_BAR;
        PG8_STAGE(PG8_SB(1, 0), cB + kstep, voffB); PG8_STAGE(PG8_SA(1, 0), cA + kstep, voffA); PG8_STAGE(PG8_SB(1, 1), cB + hstep + kstep, voffB);
        PG8_WAIT_V(6); PG8_BAR;
    } else {
        PG8_STAGE(PG8_SB(0, 0), cB, voffB); PG8_STAGE(PG8_SA(0, 0), cA, voffA); PG8_STAGE(PG8_SB(0, 1), cB + hstep, voffB); PG8_STAGE(PG8_SA(0, 1), cA + hstep, voffA);
        if (wr == 1) PG8_BAR;
        PG8_WAIT_V(4); PG8_BAR;
        PG8_STAGE(PG8_SB(1, 0), cB + kstep, voffB); PG8_STAGE(PG8_SA(1, 0), cA + kstep, voffA); PG8_STAGE(PG8_SB(1, 1), cB + hstep + kstep, voffB);
        PG8_WAIT_V(6); PG8_BAR;
    }
    for (;;) {
        const bool has_next = S.next(ui + 1, nxt);
        const char* nA = has_next ? (const char*)g.A + (size_t)nxt.pm * tstep : cA; const char* nB = has_next ? (const char*)g.Bt + (size_t)nxt.pn * tstep : cB;
        for (int t = 0; t < nt; t += 2) {
            const bool last = (t == nt - 2);
            const char* a1 = cA + (size_t)(t + 1) * kstep;
            const char* a2 = last ? nA : cA + (size_t)(t + 2) * kstep; const char* b2 = last ? nB : cB + (size_t)(t + 2) * kstep;
            const char* a3 = a2 + kstep; const char* b3 = b2 + kstep;
            if (last && has_next) S.a_ready(nxt);
            if constexpr (SP2) {
            PG8_LDB(B0, 0, 0); PG8_LDB(B1, 0, 1); PG8_SCHED; PG8_LDA(At, 0, 0); PG8_STAGE(PG8_SA(1, 1), a1 + hstep, voffA);
            PG8_WAIT_V(8); PG8_WAIT_L(0); PG8_BAR; PG8_MMA(0, 0, At, B0); PG8_MMA(0, 1, At, B1); PG8_BAR; PG8_SCHED;
            PG8_LDA(At, 0, 1); PG8_STAGE(PG8_SB(0, 0), b2, voffB); PG8_STAGE(PG8_SB(0, 1), b2 + hstep, voffB); PG8_STAGE(PG8_SA(0, 0), a2, voffA);
            PG8_WAIT_V(8); PG8_WAIT_L(0); PG8_BAR; PG8_MMA(1, 0, At, B0); PG8_MMA(1, 1, At, B1); PG8_BAR; PG8_SCHED;
            PG8_LDB(B0, 1, 0); PG8_LDB(B1, 1, 1); PG8_SCHED; PG8_LDA(At, 1, 0); PG8_STAGE(PG8_SA(0, 1), a2 + hstep, voffA);
            PG8_WAIT_V(8); PG8_WAIT_L(0); PG8_BAR; PG8_MMA(0, 0, At, B0); PG8_MMA(0, 1, At, B1); PG8_BAR; PG8_SCHED;
            PG8_LDA(At, 1, 1); PG8_STAGE(PG8_SB(1, 0), b3, voffB); PG8_STAGE(PG8_SB(1, 1), b3 + hstep, voffB); PG8_STAGE(PG8_SA(1, 0), a3, voffA);
            PG8_WAIT_V(8); PG8_WAIT_L(0); PG8_BAR; PG8_MMA(1, 0, At, B0); PG8_MMA(1, 1, At, B1); PG8_BAR; PG8_SCHED;
            } else {
            PG8_LDB(B0, 0, 0); PG8_SCHED; PG8_LDA(At, 0, 0); PG8_STAGE(PG8_SA(1, 1), a1 + hstep, voffA);
            PG8_WAIT_L(8); PG8_BAR; PG8_WAIT_L(0); PG8_MMA(0, 0, At, B0); PG8_BAR; PG8_SCHED;
            PG8_LDB(B1, 0, 1); PG8_STAGE(PG8_SB(0, 0), b2, voffB);
            PG8_BAR; PG8_WAIT_L(0); PG8_MMA(0, 1, At, B1); PG8_BAR;
            PG8_LDA(At, 0, 1); PG8_STAGE(PG8_SA(0, 0), a2, voffA);
            PG8_BAR; PG8_WAIT_L(0); PG8_MMA(1, 0, At, B0); PG8_BAR; PG8_SCHED;
            PG8_STAGE(PG8_SB(0, 1), b2 + hstep, voffB);
            PG8_WAIT_V(6); PG8_BAR; PG8_MMA(1, 1, At, B1); PG8_BAR;
            PG8_LDB(B0, 1, 0); PG8_SCHED; PG8_LDA(At, 1, 0); PG8_STAGE(PG8_SA(0, 1), a2 + hstep, voffA);
            PG8_WAIT_L(8); PG8_BAR; PG8_WAIT_L(0); PG8_MMA(0, 0, At, B0); PG8_BAR; PG8_SCHED;
            PG8_LDB(B1, 1, 1); PG8_STAGE(PG8_SB(1, 0), b3, voffB);
            PG8_BAR; PG8_WAIT_L(0); PG8_MMA(0, 1, At, B1); PG8_BAR;
            PG8_LDA(At, 1, 1); PG8_STAGE(PG8_SA(1, 0), a3, voffA);
            PG8_BAR; PG8_WAIT_L(0); PG8_MMA(1, 0, At, B0); PG8_BAR; PG8_SCHED;
            PG8_STAGE(PG8_SB(1, 1), b3 + hstep, voffB);
            PG8_WAIT_V(6); PG8_BAR; PG8_MMA(1, 1, At, B1); PG8_BAR;
            }
        }
        if constexpr (ALIGN_EPI) { if (wr == 0) PG8_BAR; }
        if constexpr (!Epi::AFTER_DRAIN) { E(acc, cur, wr, wc, fr, fq); S.done(cur); }
        if (!has_next) break;
#pragma unroll
        for (int a = 0; a < 2; ++a)
#pragma unroll
            for (int b = 0; b < 2; ++b)
#pragma unroll
                for (int m = 0; m < 4; ++m)
#pragma unroll
                    for (int n = 0; n < 2; ++n) acc[a][b][m][n] = (f32x4){0.f, 0.f, 0.f, 0.f};
        cur = nxt; cA = nA; cB = nB; ++ui;
        if constexpr (ALIGN_EPI) { if (wr == 1) PG8_BAR; }
    }
    PG8_WAIT_V(0);
    if constexpr (!ALIGN_EPI) { if (wr == 0) PG8_BAR; }
    PG8_BAR;
    if constexpr (Epi::AFTER_DRAIN) { E.fused(acc, cur, wr, wc, fr, fq, lds, wid, lane); S.done(cur); }
#undef PG8_SA
#undef PG8_SB
#undef PG8_STAGE
#undef PG8_LDA
#undef PG8_LDB
#undef PG8_MMA
#undef PG8_WAIT_V
#undef PG8_WAIT_L
#undef PG8_BAR
#undef PG8_SCHED
}
}

#define LAS __attribute__((address_space(3)))
typedef unsigned short bf16;
typedef unsigned v4u __attribute__((ext_vector_type(4)));
typedef unsigned v2u __attribute__((ext_vector_type(2)));
typedef float f32x4 __attribute__((ext_vector_type(4)));
typedef short bf16x8 __attribute__((ext_vector_type(8)));

constexpr int D = 1024, NPR = 32768, NSR = 2048, M = NPR + NSR, NC = 2816, NSEQ = 36, NTILE = M / 64;
constexpr float EPS = 1e-6f;
constexpr size_t O_Y = 0, O_NAP = 35651584, O_NBP = O_NAP + 4096, O_NPP = O_NBP + 61440, O_MKP = O_NPP + 30720, O_MVP = O_MKP + 524288,
                 O_NAS = O_MVP + 524288, O_NBS = O_NAS + 32768, O_NPS = O_NBS + 491520, O_END = O_NPS + 245760;
constexpr size_t MiB = 1u << 20;
constexpr size_t WS_WIN = 0, WS_WOUT = 12 * MiB, WS_WMEM = 16 * MiB, WS_PWT = 18 * MiB, WS_RSM = 18 * MiB + 65536, WS_SSPA = 19 * MiB, WS_SSPB = 22 * MiB,
                 WS_CTL = 24 * MiB + 512 * 1024, WS_MNB = 25 * MiB, WS_KB = 28 * MiB, WS_VT = 38 * MiB, WS_XB = 48 * MiB, WS_Y = 116 * MiB, WS_U = 184 * MiB, WS_END = 372 * MiB;
constexpr int LDS_BYTES = 135168;

struct Params { const float* in[23]; float* out; unsigned char* ws; };

__device__ __forceinline__ unsigned cvtpk(float lo, float hi) { unsigned r; asm("v_cvt_pk_bf16_f32 %0, %1, %2" : "=v"(r) : "v"(lo), "v"(hi)); return r; }
__device__ __forceinline__ float bflo(unsigned u) { return __uint_as_float(u << 16); }
__device__ __forceinline__ float bfhi(unsigned u) { return __uint_as_float(u & 0xffff0000u); }
__device__ __forceinline__ float bf1(bf16 b) { return __uint_as_float(((unsigned)b) << 16); }
__device__ __forceinline__ float sigm(float x) { return __builtin_amdgcn_rcpf(1.f + __builtin_amdgcn_exp2f(-1.44269504f * x)); }
__device__ __forceinline__ float silu(float x) { return x * sigm(x); }
__device__ __forceinline__ void unpack8(v4u u, float (&f)[8]) { f[0] = bflo(u.x); f[1] = bfhi(u.x); f[2] = bflo(u.y); f[3] = bfhi(u.y); f[4] = bflo(u.z); f[5] = bfhi(u.z); f[6] = bflo(u.w); f[7] = bfhi(u.w); }
__device__ __forceinline__ v4u pack8(const float (&f)[8]) { v4u o; o.x = cvtpk(f[0], f[1]); o.y = cvtpk(f[2], f[3]); o.z = cvtpk(f[4], f[5]); o.w = cvtpk(f[6], f[7]); return o; }
__device__ __forceinline__ float wave_sum(float v) {
#pragma unroll
    for (int o = 1; o < 64; o <<= 1) v += __shfl_xor(v, o);
    return v;
}
#define LDS_WAIT() asm volatile("s_waitcnt lgkmcnt(0)" ::: "memory")

struct EpiU {
    static constexpr bool PERM = true, AFTER_DRAIN = false;
    bf16* U; const float* ssp;
    __device__ __forceinline__ void operator()(const f32x4 (&acc)[2][2][4][2], const pg8::Unit& u, int wr, int wc, int fr, int fq) const {
        const int row0 = u.pm * 256 + wr * 64 + fr, pn = u.pn, lc = wc * 32 + 8 * fq;
        float rs[2][4];
        {
            f32x4 sq[2][4];
#pragma unroll
            for (int ai = 0; ai < 2; ++ai)
#pragma unroll
                for (int m = 0; m < 4; ++m) sq[ai][m] = *(const f32x4*)(ssp + (size_t)(row0 + ai * 128 + m * 16) * 16 + fq * 4);
#pragma unroll
            for (int ai = 0; ai < 2; ++ai)
#pragma unroll
                for (int m = 0; m < 4; ++m) {
                    float t = (sq[ai][m].x + sq[ai][m].y) + (sq[ai][m].z + sq[ai][m].w);
                    t += __shfl_xor(t, 16); t += __shfl_xor(t, 32);
                    rs[ai][m] = rsqrtf(t * (1.0f / 1024.0f) + EPS);
                }
        }
#pragma unroll
        for (int ai = 0; ai < 2; ++ai)
#pragma unroll
            for (int m = 0; m < 4; ++m) {
                const int row = row0 + ai * 128 + m * 16;
                const float rstd = rs[ai][m];
                bf16* rowp = U + (size_t)row * 2048;
                if (pn < 6) {
                    const f32x4 a0 = acc[ai][0][m][0] * rstd, a1 = acc[ai][0][m][1] * rstd, g0 = acc[ai][1][m][0] * rstd, g1 = acc[ai][1][m][1] * rstd;
                    float o[8];
                    if ((pn >> 1) == 0) {
#pragma unroll
                        for (int j = 0; j < 4; ++j) { o[j] = a0[j] * silu(g0[j]); o[4 + j] = a1[j] * silu(g1[j]); }
                    } else if ((pn >> 1) == 1) {
#pragma unroll
                        for (int j = 0; j < 4; ++j) { o[j] = a0[j] * g0[j]; o[4 + j] = a1[j] * g1[j]; }
                    } else {
#pragma unroll
                        for (int j = 0; j < 4; ++j) { o[j] = a0[j] * sigm(g0[j]); o[4 + j] = a1[j] * sigm(g1[j]); }
                    }
                    *(v4u*)(rowp + (pn >> 1) * 256 + (pn & 1) * 128 + lc) = pack8(o);
                } else {
                    const float sc = (pn == 9) ? rstd * (0.125f * 1.44269504f) : rstd;
                    const bool act = (pn & 1) == 0;
#pragma unroll
                    for (int bj = 0; bj < 2; ++bj) {
                        const f32x4 v0 = acc[ai][bj][m][0] * sc, v1 = acc[ai][bj][m][1] * sc;
                        float o[8];
#pragma unroll
                        for (int j = 0; j < 4; ++j) { o[j] = act ? silu(v0[j]) : v0[j]; o[4 + j] = act ? silu(v1[j]) : v1[j]; }
                        *(v4u*)(rowp + 768 + (pn - 6) * 256 + bj * 128 + lc) = pack8(o);
                    }
                }
            }
    }
};
struct EpiX {
    static constexpr bool PERM = true, AFTER_DRAIN = false;
    bf16* XB; float* ssp; bf16* XO;
    __device__ __forceinline__ void operator()(const f32x4 (&acc)[2][2][4][2], const pg8::Unit& u, int wr, int wc, int fr, int fq) const {
        const int row0 = u.pm * 256 + wr * 64 + fr, col0 = u.pn * 256 + wc * 32 + 8 * fq;
#pragma unroll
        for (int ai = 0; ai < 2; ++ai) {
            v4u xv[4][2];
#pragma unroll
            for (int m = 0; m < 4; ++m)
#pragma unroll
                for (int bj = 0; bj < 2; ++bj) xv[m][bj] = *(const v4u*)(XB + (size_t)(row0 + ai * 128 + m * 16) * D + col0 + bj * 128);
#pragma unroll
            for (int m = 0; m < 4; ++m) {
                const int row = row0 + ai * 128 + m * 16;
                float ss = 0.f;
#pragma unroll
                for (int bj = 0; bj < 2; ++bj) {
                    float xo[8]; unpack8(xv[m][bj], xo);
                    const f32x4 a0 = acc[ai][bj][m][0], a1 = acc[ai][bj][m][1];
#pragma unroll
                    for (int j = 0; j < 4; ++j) { xo[j] += a0[j]; xo[4 + j] += a1[j]; }
#pragma unroll
                    for (int j = 0; j < 8; ++j) ss += xo[j] * xo[j];
                    *(v4u*)(XO + (size_t)row * D + col0 + bj * 128) = pack8(xo);
                }
                ss += __shfl_xor(ss, 16); ss += __shfl_xor(ss, 32);
                if (fq == 0) ssp[(size_t)row * 16 + u.pn * 4 + wc] = ss;
            }
        }
    }
};
struct EpiKV {
    static constexpr bool PERM = false, AFTER_DRAIN = true;
    const float* rsm; float* out; bf16* KB; bf16* VT;
    __device__ __forceinline__ void operator()(const f32x4 (&)[2][2][4][2], const pg8::Unit&, int, int, int, int) const {}
    __device__ __forceinline__ void fused(f32x4 (&acc)[2][2][4][2], const pg8::Unit& u, int wr, int wc, int fr, int fq, PG8_LAS unsigned char* lds, int wid, int lane) const {
        const int l = u.pn >> 1, isv = u.pn & 1, b = u.pm;
        const int mem0 = wr * 64 + fr, c0 = wc * 32 + 4 * fq;
        float* ob = out + O_MKP + (size_t)isv * (O_MVP - O_MKP) + (size_t)(l * 4 + b) * 65536;
        PG8_LAS bf16* img = (PG8_LAS bf16*)lds;
#pragma unroll
        for (int ai = 0; ai < 2; ++ai)
#pragma unroll
            for (int m = 0; m < 4; ++m) {
                const int mem = mem0 + ai * 128 + m * 16;
                const float rs = rsm[b * 256 + mem];
#pragma unroll
                for (int bj = 0; bj < 2; ++bj)
#pragma unroll
                    for (int n = 0; n < 2; ++n) {
                        const int c = c0 + bj * 128 + n * 16;
                        const f32x4 v = acc[ai][bj][m][n] * rs;
                        *(f32x4*)(ob + (size_t)mem * 256 + c) = v;
                        const int h = c >> 6, d = c & 63;
                        const unsigned w0 = cvtpk(v[0], v[1]), w1 = cvtpk(v[2], v[3]);
                        if (!isv) {
                            const int mt = (mem >> 5) * 2 + ((mem >> 2) & 1), r = ((mem >> 3) & 3) * 4 + (mem & 3), kk = d >> 5, q = (d >> 3) & 3, e = d & 7;
                            *(PG8_LAS v2u*)(img + ((h * 32 + mt * 2 + kk) * 512 + (q * 16 + r) * 8 + e)) = (v2u){w0, w1};
                        } else {
                            const int mp = mem >> 5, q = (mem >> 3) & 3, e = mem & 7, dt = d >> 4, r = d & 15;
                            PG8_LAS bf16* vp = img + ((h * 32 + mp * 4 + dt) * 512 + (q * 16 + r) * 8 + e);
                            vp[0] = (bf16)(w0 & 0xffffu); vp[8] = (bf16)(w0 >> 16); vp[16] = (bf16)(w1 & 0xffffu); vp[24] = (bf16)(w1 >> 16);
                        }
                    }
            }
        asm volatile("s_waitcnt lgkmcnt(0)" ::: "memory"); __builtin_amdgcn_s_barrier(); asm volatile("" ::: "memory");
        bf16* dst = KB + (ptrdiff_t)isv * (VT - KB) + (size_t)(l * NSEQ + b) * 65536;
        const int tid = wid * 64 + lane;
#pragma unroll
        for (int i = 0; i < 16; ++i) { const int ch = tid + 512 * i; *(v4u*)(dst + (size_t)ch * 8) = *(const PG8_LAS v4u*)(img + ch * 8); }
        asm volatile("s_waitcnt lgkmcnt(0)" ::: "memory"); __builtin_amdgcn_s_barrier(); asm volatile("" ::: "memory");
    }
};

__device__ __forceinline__ void transpose_item(const float* W, int K, int N, bf16* WT, int row_off, const float* gs, LAS float* scr, int item, int lane, bool remap = false) {
    const int nblk = N / 32, kb = item / nblk, nb = item % nblk, k0 = 64 * kb, n0 = 32 * nb;
    int d0 = n0;
    if (remap) { const int sp = n0 >> 8, ch = n0 & 255; if (sp < 6) { const int pair = (sp == 0 || sp == 3) ? 0 : ((sp == 1 || sp == 2) ? 1 : 2), bj = (sp == 3 || sp == 2 || sp == 5) ? 1 : 0; d0 = (pair * 2 + (ch >> 7)) * 256 + bj * 128 + (ch & 127); } }
    f32x4 tv[8];
#pragma unroll
    for (int i = 0; i < 8; ++i) { const int kk = 8 * i + (lane >> 3); tv[i] = *(const f32x4*)(W + (size_t)(k0 + kk) * N + n0 + (lane & 7) * 4); }
#pragma unroll
    for (int i = 0; i < 8; ++i) { const int kk = 8 * i + (lane >> 3); f32x4 v = tv[i]; if (gs) v = v * gs[k0 + kk];
        LAS float* d = scr + kk * 33 + (lane & 7) * 4; d[0] = v.x; d[1] = v.y; d[2] = v.z; d[3] = v.w; }
    LDS_WAIT();
    const int c = lane & 7;
#pragma unroll
    for (int j = 0; j < 4; ++j) { const int n = (lane >> 3) + 8 * j; const LAS float* s = scr + (8 * c) * 33 + n;
        v4u o; o.x = cvtpk(s[0 * 33], s[1 * 33]); o.y = cvtpk(s[2 * 33], s[3 * 33]); o.z = cvtpk(s[4 * 33], s[5 * 33]); o.w = cvtpk(s[6 * 33], s[7 * 33]);
        *(v4u*)(WT + (size_t)(row_off + d0 + n) * K + k0 + 8 * c) = o; }
    LDS_WAIT();
}
__device__ __forceinline__ float row_to_bf16(const float* xrow, bf16* orow, int lane) {
    const f32x4* xr = (const f32x4*)xrow + lane;
    f32x4 v[4]; float s = 0.f;
#pragma unroll
    for (int j = 0; j < 4; ++j) { v[j] = xr[64 * j]; s += (v[j].x * v[j].x + v[j].y * v[j].y) + (v[j].z * v[j].z + v[j].w * v[j].w); }
    s = wave_sum(s);
    v2u* o8 = (v2u*)orow + lane;
#pragma unroll
    for (int j = 0; j < 4; ++j) { v2u w; w.x = cvtpk(v[j].x, v[j].y); w.y = cvtpk(v[j].z, v[j].w); o8[64 * j] = w; }
    return s;
}

constexpr int UC = 2048, C_ABG = 0, C_V = 256, C_GLU = 512, C_SBG = 768, C_CU = 1024, C_SCG = 1280, C_Q = 1536, C_SXG = 1792;
struct Lay {
    const bf16* U; bf16* Y; const bf16* KB; const bf16* VT; const bf16* PWT;
    const float *caw, *cbw, *cbb, *lng, *lnb, *pbias, *pscale, *sta, *stb, *stp;
    float* out; int l;
};
struct Tile { int row0, seq, t0, first, last, samp, b; };
__device__ __forceinline__ Tile mk_tile(int tt) {
    Tile T; T.row0 = tt * 64;
    if (tt < 512) { T.seq = tt >> 7; T.t0 = (tt & 127) * 64; T.first = (tt & 127) == 0; T.last = (tt & 127) == 127; T.samp = 0; T.b = T.seq; }
    else { T.seq = 4 + (tt - 512); T.t0 = 0; T.first = 1; T.last = 1; T.samp = 1; T.b = tt - 512; }
    return T;
}
__device__ __forceinline__ void ld8f(const float* s, float (&f)[8]) { const f32x4 a = *(const f32x4*)s, b = *(const f32x4*)(s + 4); f[0] = a.x; f[1] = a.y; f[2] = a.z; f[3] = a.w; f[4] = b.x; f[5] = b.y; f[6] = b.z; f[7] = b.w; }

__device__ __forceinline__ void mix_a(const Lay& L, const Tile& T, int tid) {
    asm volatile("" : "+v"(tid));
    const int c0 = (tid & 31) * 8, tq = tid >> 5;
    const bf16* ub = L.U + (size_t)(T.row0 + tq * 4) * UC + c0;
    const bool hist = T.first && tq == 0;
    v4u rv[6], rb[4];
#pragma unroll
    for (int jj = 0; jj < 6; ++jj) rv[jj] = (jj >= 2 || !hist) ? __builtin_nontemporal_load((const v4u*)(ub + (jj - 2) * UC + C_V)) : (v4u){0u, 0u, 0u, 0u};
#pragma unroll
    for (int j = 0; j < 4; ++j) rb[j] = __builtin_nontemporal_load((const v4u*)(ub + j * UC + C_ABG));
    float w[3][8];
#pragma unroll
    for (int k = 0; k < 3; ++k) ld8f(L.caw + k * 256 + c0, w[k]);
    float v[6][8];
#pragma unroll
    for (int jj = 0; jj < 6; ++jj) unpack8(rv[jj], v[jj]);
    if (hist && T.samp) { ld8f(L.sta + ((size_t)T.b * 2 + 0) * 256 + c0, v[0]); ld8f(L.sta + ((size_t)T.b * 2 + 1) * 256 + c0, v[1]); }
#pragma unroll
    for (int j = 0; j < 4; ++j) {
        float fb[8], y[8]; unpack8(rb[j], fb);
#pragma unroll
        for (int i = 0; i < 8; ++i) y[i] = fb[i] * (w[0][i] * v[j][i] + w[1][i] * v[j + 1][i] + w[2][i] * v[j + 2][i]);
        *(v4u*)(L.Y + (size_t)(T.row0 + tq * 4 + j) * D + c0) = pack8(y);
    }
    if (T.last && tq == 15) {
#pragma unroll
        for (int j2 = 0; j2 < 2; ++j2) {
            float* dst = L.out + (T.samp ? O_NAS + ((size_t)(L.l * 32 + T.b) * 2 + j2) * 256 : O_NAP + ((size_t)(L.l * 4 + T.b) * 2 + j2) * 256) + c0;
            *(f32x4*)dst = (f32x4){v[4 + j2][0], v[4 + j2][1], v[4 + j2][2], v[4 + j2][3]};
            *(f32x4*)(dst + 4) = (f32x4){v[4 + j2][4], v[4 + j2][5], v[4 + j2][6], v[4 + j2][7]};
        }
    }
}

__device__ __forceinline__ void mix_b(const Lay& L, const Tile& T, int tid, LAS unsigned char* lds) {
    asm volatile("" : "+v"(tid));
    LAS float* G = (LAS float*)lds;
    LAS float* red = (LAS float*)(lds + 98304);
    LAS bf16* SB = (LAS bf16*)(lds + 100352);
    LAS float* stat = (LAS float*)(lds + 133632);
    const int c = tid & 255, th = tid >> 8, lane = tid & 63, wq = (tid >> 6) & 3;
    float w[31];
    {
        v4u rg[6], rs[4];
#pragma unroll
        for (int k = 0; k < 6; ++k) {
            const int i = tid + 512 * k, r = i >> 5, c0 = (i & 31) * 8, tt = r - 30;
            rg[k] = (i < 94 * 32 && (tt >= 0 || !T.first)) ? __builtin_nontemporal_load((const v4u*)(L.U + (size_t)(T.row0 + tt) * UC + C_GLU + c0)) : (v4u){0u, 0u, 0u, 0u};
        }
#pragma unroll
        for (int k = 0; k < 4; ++k) { const int i = tid + 512 * k, r = i >> 5, c0 = (i & 31) * 8; rs[k] = __builtin_nontemporal_load((const v4u*)(L.U + (size_t)(T.row0 + r) * UC + C_SBG + c0)); }
#pragma unroll
        for (int k = 0; k < 31; ++k) w[k] = L.cbw[k * 256 + c];
#pragma unroll
        for (int k = 0; k < 6; ++k) {
            const int i = tid + 512 * k, r = i >> 5, c0 = (i & 31) * 8, tt = r - 30;
            if (i < 94 * 32) {
                float g8[8]; unpack8(rg[k], g8);
                if (tt < 0 && T.first && T.samp) ld8f(L.stb + ((size_t)T.b * 30 + r) * 256 + c0, g8);
                *(LAS f32x4*)(G + r * 256 + c0) = (f32x4){g8[0], g8[1], g8[2], g8[3]};
                *(LAS f32x4*)(G + r * 256 + c0 + 4) = (f32x4){g8[4], g8[5], g8[6], g8[7]};
            }
        }
#pragma unroll
        for (int k = 0; k < 4; ++k) { const int i = tid + 512 * k; *(LAS v4u*)(SB + i * 8) = rs[k]; }
    }
    __syncthreads();
    const float bias = L.cbb[c];
    float z[4][8];
    {
        float g[62];
#pragma unroll
        for (int i = 0; i < 62; ++i) g[i] = G[(th * 32 + i) * 256 + c];
#pragma unroll
        for (int ch = 0; ch < 4; ++ch)
#pragma unroll
            for (int j = 0; j < 8; ++j) {
                float a = bias;
#pragma unroll
                for (int k = 0; k < 31; ++k) a += w[k] * g[ch * 8 + j + k];
                z[ch][j] = a;
            }
    }
    const bool b5 = (lane & 32) != 0, b4 = (lane & 16) != 0, b3 = (lane & 8) != 0;
#pragma unroll
    for (int ch = 0; ch < 4; ++ch) {
        const int tb = th * 32 + ch * 8;
        float r1[4], r2[4];
#pragma unroll
        for (int i = 0; i < 4; ++i) {
            const float za = z[ch][i], zb = z[ch][4 + i];
            const float k1 = b5 ? zb : za, s1 = b5 ? za : zb;
            r1[i] = k1 + __shfl_xor(s1, 32);
            const float k2 = b5 ? zb * zb : za * za, s2 = b5 ? za * za : zb * zb;
            r2[i] = k2 + __shfl_xor(s2, 32);
        }
        float q1[2], q2[2];
#pragma unroll
        for (int i = 0; i < 2; ++i) {
            const float k1 = b4 ? r1[2 + i] : r1[i], s1 = b4 ? r1[i] : r1[2 + i];
            q1[i] = k1 + __shfl_xor(s1, 16);
            const float k2 = b4 ? r2[2 + i] : r2[i], s2 = b4 ? r2[i] : r2[2 + i];
            q2[i] = k2 + __shfl_xor(s2, 16);
        }
        float d1 = (b3 ? q1[1] : q1[0]) + __shfl_xor(b3 ? q1[0] : q1[1], 8);
        float d2 = (b3 ? q2[1] : q2[0]) + __shfl_xor(b3 ? q2[0] : q2[1], 8);
        d1 += __shfl_xor(d1, 4); d1 += __shfl_xor(d1, 2); d1 += __shfl_xor(d1, 1);
        d2 += __shfl_xor(d2, 4); d2 += __shfl_xor(d2, 2); d2 += __shfl_xor(d2, 1);
        if ((lane & 7) == 0) { red[(tb + (lane >> 3)) * 8 + wq * 2] = d1; red[(tb + (lane >> 3)) * 8 + wq * 2 + 1] = d2; }
    }
    __syncthreads();
    if (T.last) {
        float* dst = L.out + (T.samp ? O_NBS + (size_t)(L.l * 32 + T.b) * 30 * 256 : O_NBP + (size_t)(L.l * 4 + T.b) * 30 * 256);
        for (int i = tid; i < 30 * 256; i += 512) dst[i] = G[64 * 256 + i];
    }
    if (tid < 64) {
        const f32x4 ra = *(LAS f32x4*)(red + tid * 8), rb = *(LAS f32x4*)(red + tid * 8 + 4);
        const float S1 = (ra.x + ra.z) + (rb.x + rb.z), S2 = (ra.y + ra.w) + (rb.y + rb.w);
        const float mu = S1 * (1.f / 256.f), var = S2 * (1.f / 256.f) - mu * mu;
        stat[tid * 2] = mu; stat[tid * 2 + 1] = rsqrtf(fmaxf(var, 0.f) + EPS);
    }
    const float lg = L.lng[c], lb = L.lnb[c];
    __syncthreads();
    {
        typedef float f32x2v __attribute__((ext_vector_type(2)));
        f32x2v st[4][8]; float gt[4][8];
#pragma unroll
        for (int ch = 0; ch < 4; ++ch)
#pragma unroll
            for (int j = 0; j < 8; ++j) { const int t = th * 32 + ch * 8 + j; st[ch][j] = *(const LAS f32x2v*)(stat + t * 2); gt[ch][j] = bf1(SB[t * 256 + c]); }
#pragma unroll
        for (int ch = 0; ch < 4; ++ch)
#pragma unroll
            for (int j = 0; j < 8; ++j) {
                const float zn = (z[ch][j] - st[ch][j].x) * (st[ch][j].y * lg) + lb;
                gt[ch][j] = silu(zn) * gt[ch][j];
            }
#pragma unroll
        for (int ch = 0; ch < 4; ++ch)
#pragma unroll
            for (int j = 0; j < 8; ++j) { const int t = th * 32 + ch * 8 + j; SB[t * 256 + c] = (bf16)(cvtpk(gt[ch][j], 0.f) & 0xffffu); }
    }
    __syncthreads();
#pragma unroll
    for (int k = 0; k < 4; ++k) { const int i = tid + 512 * k, r = i >> 5, c0 = (i & 31) * 8; *(v4u*)(L.Y + (size_t)(T.row0 + r) * D + 256 + c0) = *(LAS v4u*)(SB + i * 8); }
    __syncthreads();
}

__device__ __forceinline__ void mix_c(const Lay& L, const Tile& T, int tid, LAS unsigned char* lds) {
    asm volatile("" : "+v"(tid));
    LAS float* P = (LAS float*)lds;
    LAS bf16* Dm = (LAS bf16*)(lds + 81920);
    const int wave = tid >> 6, lane = tid & 63, mg = wave & 3, mth = wave >> 2, mr = lane & 15, mq = lane >> 4;
    v2u cg2[4][2];
    bf16x8 af[4][2];
    {
        v4u rg[5];
#pragma unroll
        for (int k = 0; k < 5; ++k) {
            const int i = tid + 512 * k, r = i >> 5, c0 = (i & 31) * 8, tt = r - 15;
            rg[k] = (i < 79 * 32 && (tt >= 0 || !T.first)) ? __builtin_nontemporal_load((const v4u*)(L.U + (size_t)(T.row0 + tt) * UC + C_CU + c0)) : (v4u){0u, 0u, 0u, 0u};
        }
#pragma unroll
        for (int mt = 0; mt < 4; ++mt)
#pragma unroll
            for (int nt = 0; nt < 2; ++nt) cg2[mt][nt] = *(const v2u*)(L.U + (size_t)(T.row0 + mth * 32 + nt * 16 + mr) * UC + C_SCG + mg * 64 + mt * 16 + 4 * mq);
#pragma unroll
        for (int mt = 0; mt < 4; ++mt)
#pragma unroll
            for (int kk = 0; kk < 2; ++kk) af[mt][kk] = *(const bf16x8*)(L.PWT + ((size_t)(mg * 64 + mt * 16 + mr)) * 64 + kk * 32 + mq * 8);
#pragma unroll
        for (int k = 0; k < 5; ++k) {
            const int i = tid + 512 * k, r = i >> 5, c0 = (i & 31) * 8, tt = r - 15;
            if (i < 79 * 32) {
                float g8[8]; unpack8(rg[k], g8);
                if (tt < 0 && T.first && T.samp) ld8f(L.stp + ((size_t)T.b * 15 + r) * 256 + c0, g8);
                *(LAS f32x4*)(P + r * 256 + c0) = (f32x4){g8[0], g8[1], g8[2], g8[3]};
                *(LAS f32x4*)(P + r * 256 + c0 + 4) = (f32x4){g8[4], g8[5], g8[6], g8[7]};
            }
        }
    }
    __syncthreads();
    {
        const int c = tid & 255, th = tid >> 8, g = __builtin_amdgcn_readfirstlane(c >> 6), w = 2 << g;
        const LAS float* Pc = P + th * 32 * 256 + c;
        float x[47], cur[32];
#pragma unroll
        for (int i = 0; i < 47; ++i) x[i] = Pc[i * 256];
#pragma unroll
        for (int i = 0; i < 32; ++i) cur[i] = x[15 + i];
#pragma unroll
        for (int i = 46; i >= 1; --i) x[i] += x[i - 1];
        if (g >= 1) {
#pragma unroll
            for (int i = 46; i >= 3; --i) x[i] += x[i - 2];
        }
        if (g >= 2) {
#pragma unroll
            for (int i = 46; i >= 7; --i) x[i] += x[i - 4];
        }
        if (g >= 3) {
#pragma unroll
            for (int i = 46; i >= 15; --i) x[i] += x[i - 8];
        }
        const int pos1 = (T.samp ? 1024 : 0) + T.t0 + th * 32 + 1;
        const float rw = __builtin_amdgcn_rcpf((float)w);
#pragma unroll
        for (int i = 0; i < 32; ++i) {
            const float rc = (pos1 + i >= w) ? rw : __builtin_amdgcn_rcpf((float)(pos1 + i));
            const float d = x[15 + i] * rc - cur[i];
            Dm[(th * 32 + i) * 264 + c] = (bf16)(cvtpk(d, 0.f) & 0xffffu);
        }
    }
    __syncthreads();
    if (T.last) {
        float* dst = L.out + (T.samp ? O_NPS + (size_t)(L.l * 32 + T.b) * 15 * 256 : O_NPP + (size_t)(L.l * 4 + T.b) * 15 * 256);
        for (int i = tid; i < 15 * 256; i += 512) dst[i] = P[64 * 256 + i];
    }
    {
        bf16x8 bfr[2][2];
#pragma unroll
        for (int nt = 0; nt < 2; ++nt)
#pragma unroll
            for (int kk = 0; kk < 2; ++kk) bfr[nt][kk] = *(const LAS bf16x8*)(Dm + (mth * 32 + nt * 16 + mr) * 264 + mg * 64 + kk * 32 + mq * 8);
        f32x4 acc[4][2];
#pragma unroll
        for (int mt = 0; mt < 4; ++mt)
#pragma unroll
            for (int nt = 0; nt < 2; ++nt) {
                f32x4 a = (f32x4){0.f, 0.f, 0.f, 0.f};
                a = __builtin_amdgcn_mfma_f32_16x16x32_bf16(af[mt][0], bfr[nt][0], a, 0, 0, 0);
                a = __builtin_amdgcn_mfma_f32_16x16x32_bf16(af[mt][1], bfr[nt][1], a, 0, 0, 0);
                acc[mt][nt] = a;
            }
#pragma unroll
        for (int mt = 0; mt < 4; ++mt) {
            const int chn = mg * 64 + mt * 16 + 4 * mq;
            const f32x4 pb = *(const f32x4*)(L.pbias + chn), ps = *(const f32x4*)(L.pscale + chn);
#pragma unroll
            for (int nt = 0; nt < 2; ++nt) {
                const size_t row = (size_t)(T.row0 + mth * 32 + nt * 16 + mr);
                const float y0 = (acc[mt][nt][0] + pb.x) * ps.x * bflo(cg2[mt][nt].x), y1 = (acc[mt][nt][1] + pb.y) * ps.y * bfhi(cg2[mt][nt].x);
                const float y2 = (acc[mt][nt][2] + pb.z) * ps.z * bflo(cg2[mt][nt].y), y3 = (acc[mt][nt][3] + pb.w) * ps.w * bfhi(cg2[mt][nt].y);
                v2u o; o.x = cvtpk(y0, y1); o.y = cvtpk(y2, y3);
                *(v2u*)(L.Y + row * D + 512 + chn) = o;
            }
        }
    }
    __syncthreads();
}

__device__ __forceinline__ void mix_x(const Lay& L, const Tile& T, int hp, int tid, LAS unsigned char* lds) {
    asm volatile("" : "+v"(tid));
    const int wave = __builtin_amdgcn_readfirstlane(tid >> 6), lane = tid & 63, hl = wave >> 2, h = hp * 2 + hl, nt = wave & 3, r = lane & 15, q = lane >> 4;
    {
        const char* ksrc = (const char*)(L.KB + ((size_t)T.seq * 4 + hp * 2) * 16384);
        const char* vsrc = (const char*)(L.VT + ((size_t)T.seq * 4 + hp * 2) * 16384);
#pragma unroll
        for (int i = 0; i < 8; ++i) {
            const int cb = i * 8 + wave;
            const int dst = (cb >> 5) * 65536 + (cb & 31) * 1024;
            __builtin_amdgcn_global_load_lds((const unsigned*)(ksrc + (size_t)cb * 1024 + lane * 16), (LAS unsigned*)(lds + dst), 16, 0, 0);
            __builtin_amdgcn_global_load_lds((const unsigned*)(vsrc + (size_t)cb * 1024 + lane * 16), (LAS unsigned*)(lds + dst + 32768), 16, 0, 0);
        }
    }
    const size_t row = (size_t)(T.row0 + nt * 16 + r);
    bf16x8 qf[2];
#pragma unroll
    for (int kk = 0; kk < 2; ++kk) qf[kk] = *(const bf16x8*)(L.U + row * UC + C_Q + h * 64 + kk * 32 + q * 8);
    v2u xg[4];
#pragma unroll
    for (int dt = 0; dt < 4; ++dt) xg[dt] = *(const v2u*)(L.U + row * UC + C_SXG + h * 64 + dt * 16 + 4 * q);
    asm volatile("s_waitcnt vmcnt(0)" ::: "memory");
    __syncthreads();
    const LAS bf16x8* Kf = (const LAS bf16x8*)(lds + hl * 65536) + lane;
    const LAS bf16x8* Vf = (const LAS bf16x8*)(lds + hl * 65536 + 32768) + lane;
    f32x4 s[16];
#pragma unroll
    for (int mt = 0; mt < 16; ++mt) {
        const bf16x8 k0 = Kf[(mt * 2) * 64], k1 = Kf[(mt * 2 + 1) * 64];
        f32x4 a = (f32x4){0.f, 0.f, 0.f, 0.f};
        a = __builtin_amdgcn_mfma_f32_16x16x32_bf16(k0, qf[0], a, 0, 0, 0);
        a = __builtin_amdgcn_mfma_f32_16x16x32_bf16(k1, qf[1], a, 0, 0, 0);
        s[mt] = a;
    }
    float mx = -3.0e38f;
#pragma unroll
    for (int mt = 0; mt < 16; ++mt) mx = fmaxf(mx, fmaxf(fmaxf(s[mt][0], s[mt][1]), fmaxf(s[mt][2], s[mt][3])));
    mx = fmaxf(mx, __shfl_xor(mx, 16)); mx = fmaxf(mx, __shfl_xor(mx, 32));
    float sum = 0.f;
#pragma unroll
    for (int mt = 0; mt < 16; ++mt)
#pragma unroll
        for (int j = 0; j < 4; ++j) { const float pv = __builtin_amdgcn_exp2f(s[mt][j] - mx); s[mt][j] = pv; sum += pv; }
    sum += __shfl_xor(sum, 16); sum += __shfl_xor(sum, 32);
    const float inv = 1.0f / sum;
    f32x4 o[4];
#pragma unroll
    for (int dt = 0; dt < 4; ++dt) o[dt] = (f32x4){0.f, 0.f, 0.f, 0.f};
#pragma unroll
    for (int mp = 0; mp < 8; ++mp) {
        v4u pk; pk.x = cvtpk(s[2 * mp][0], s[2 * mp][1]); pk.y = cvtpk(s[2 * mp][2], s[2 * mp][3]);
        pk.z = cvtpk(s[2 * mp + 1][0], s[2 * mp + 1][1]); pk.w = cvtpk(s[2 * mp + 1][2], s[2 * mp + 1][3]);
        const bf16x8 pf = __builtin_bit_cast(bf16x8, pk);
#pragma unroll
        for (int dt = 0; dt < 4; ++dt) o[dt] = __builtin_amdgcn_mfma_f32_16x16x32_bf16(Vf[(mp * 4 + dt) * 64], pf, o[dt], 0, 0, 0);
    }
#pragma unroll
    for (int dt = 0; dt < 4; ++dt) {
        const float y0 = o[dt][0] * inv * bflo(xg[dt].x), y1 = o[dt][1] * inv * bfhi(xg[dt].x);
        const float y2 = o[dt][2] * inv * bflo(xg[dt].y), y3 = o[dt][3] * inv * bfhi(xg[dt].y);
        v2u ov; ov.x = cvtpk(y0, y1); ov.y = cvtpk(y2, y3);
        *(v2u*)(L.Y + row * D + 768 + h * 64 + dt * 16 + 4 * q) = ov;
    }
    __syncthreads();
}

#define XB_TMO      128
#define XB_XCNT(j)  (256  + 64 * (j))
#define XB_XSUB(j)  (1280 + 64 * (j))
#define XB_XGEN(j)  (2304 + 64 * (j))
#define XB_TOP      3328
#define XB_TOPGEN   3392
#define XCD_BAR_WORDS 3456
#define XB_SPIN_CAP (1u << 18)

__device__ __forceinline__ unsigned xb_ld(unsigned* p)              { return __hip_atomic_load(p, __ATOMIC_RELAXED, __HIP_MEMORY_SCOPE_AGENT); }
__device__ __forceinline__ unsigned xb_add(unsigned* p, unsigned v) { return __hip_atomic_fetch_add(p, v, __ATOMIC_RELAXED, __HIP_MEMORY_SCOPE_AGENT); }
__device__ __forceinline__ unsigned xb_xcc_id() { return (unsigned)__builtin_amdgcn_s_getreg((3 << 11) | 20) & 0xFu; }
#define XB_SPIN(cond, bar) do { unsigned _sp = 0; while (cond) { __builtin_amdgcn_s_sleep(1); \
    if ((++_sp & 255u) == 0u) { if (xb_ld(&(bar)[XB_TMO])) break; if (_sp > XB_SPIN_CAP) { atomicAdd(&(bar)[XB_TMO], 1u); break; } } } } while (0)

struct XcdBarrier {
    unsigned* bar; unsigned x;
    volatile LAS unsigned* st;
};

__device__ __forceinline__ XcdBarrier xcd_barrier_post(unsigned* bar, volatile LAS unsigned* st) {
    XcdBarrier b; b.bar = bar; b.x = xb_xcc_id(); b.st = st;
    if (threadIdx.x == 0) (void)xb_add(&bar[XB_XCNT(b.x)], 1u);
    return b;
}
__device__ __forceinline__ void xcd_barrier_complete(unsigned* bar, unsigned x, unsigned& nloc, unsigned& nx) {
    const unsigned G = gridDim.x * gridDim.y * gridDim.z;
    unsigned sum, cnt, mine, sp = 0u;
    for (;;) {
        sum = 0u; cnt = 0u; mine = 0u;
#pragma unroll
        for (unsigned j = 0; j < 16; ++j) { const unsigned c = xb_ld(&bar[XB_XCNT(j)]); sum += c; cnt += (c > 0u) ? 1u : 0u; mine = (j == x) ? c : mine; }
        if (sum == G) break;
        __builtin_amdgcn_s_sleep(1);
        if ((++sp & 255u) == 0u) { if (xb_ld(&bar[XB_TMO])) break; if (sp > XB_SPIN_CAP) { atomicAdd(&bar[XB_TMO], 1u); break; } }
    }
    nloc = mine > 0u ? mine : 1u; nx = cnt > 0u ? cnt : 1u;
}

__device__ __forceinline__ void xcd_barrier(const XcdBarrier& b) {
    asm volatile("s_waitcnt vmcnt(0)" ::: "memory");
    __syncthreads();
    if (threadIdx.x == 0) {
        unsigned* bar = b.bar;
        __builtin_amdgcn_s_waitcnt(0);
        unsigned nloc = b.st[0], nx = b.st[1];
        if (nloc == 0u) { xcd_barrier_complete(bar, b.x, nloc, nx); b.st[0] = nloc; b.st[1] = nx; }
        const unsigned old = xb_add(&bar[XB_XSUB(b.x)], 1u);
        const unsigned gen = old / nloc;
        if (old + 1u == (gen + 1u) * nloc) {
            __builtin_amdgcn_fence(__ATOMIC_RELEASE, "agent");
            asm volatile("s_waitcnt vmcnt(0)" ::: "memory");
            const unsigned og = xb_add(&bar[XB_TOP], 1u);
            const unsigned tg = og / nx;
            if (og + 1u == (tg + 1u) * nx) xb_add(&bar[XB_TOPGEN], 1u);
            else XB_SPIN(xb_ld(&bar[XB_TOPGEN]) == tg, bar);
            __builtin_amdgcn_fence(__ATOMIC_ACQUIRE, "agent");
            xb_add(&bar[XB_XGEN(b.x)], 1u);
            asm volatile("s_waitcnt vmcnt(0)" ::: "memory");
        } else {
            XB_SPIN(xb_ld(&bar[XB_XGEN(b.x)]) == gen, bar);
            __builtin_amdgcn_fence(__ATOMIC_ACQUIRE, "agent");
            asm volatile("s_waitcnt vmcnt(0)" ::: "memory");
        }
    }
    __syncthreads();
}

#define WIN ((bf16*)(ws + WS_WIN))
#define WOUT ((bf16*)(ws + WS_WOUT))
#define WMEM ((bf16*)(ws + WS_WMEM))
#define W_PWT ((bf16*)(ws + WS_PWT))
#define RSM ((float*)(ws + WS_RSM))
#define SSPA ((float*)(ws + WS_SSPA))
#define SSPB ((float*)(ws + WS_SSPB))
#define MNB ((bf16*)(ws + WS_MNB))
#define W_KB ((bf16*)(ws + WS_KB))
#define W_VT ((bf16*)(ws + WS_VT))
#define XB ((bf16*)(ws + WS_XB))
#define YB ((bf16*)(ws + WS_Y))
#define UB ((bf16*)(ws + WS_U))
#define PHASE_WS __attribute__((address_space(1))) unsigned char* wsg_ = (__attribute__((address_space(1))) unsigned char*)p.ws; asm volatile("" : "+s"(wsg_)); unsigned char* ws = (unsigned char*)wsg_;
__global__ void __launch_bounds__(512, 2) hymba_fwd(Params p) {
    extern __shared__ __attribute__((aligned(16))) unsigned char lds_raw[];
    LAS unsigned char* lds = (LAS unsigned char*)lds_raw;
    cg::grid_group grid = cg::this_grid();
    const int tid = threadIdx.x, lane = tid & 63, wave = __builtin_amdgcn_readfirstlane(tid >> 6);
    const int G = gridDim.x, bx = blockIdx.x;
    if (tid < 2) ((LAS unsigned*)(lds + 133120))[tid] = 0u;
    __syncthreads();
    const XcdBarrier bar = xcd_barrier_post((unsigned*)(p.ws + WS_CTL), (volatile LAS unsigned*)(lds + 133120));

    {
        PHASE_WS
        const float* xp = p.in[0]; const float* xs = p.in[1];
        LAS float* scr = (LAS float*)(lds + wave * 16384);
        const int gw = bx * 8 + wave, NGW = G * 8;
        constexpr int I_IN = 16 * 88, I_OUT = 16 * 32, I_MEM = 16 * 8, I_L = I_IN + I_OUT + 2 * I_MEM;
        for (int it = gw; it < 2 * I_L; it += NGW) {
            const int l = it / I_L; int r = it % I_L;
            if (r < I_IN) { transpose_item(p.in[9] + (size_t)l * D * NC, D, NC, WIN + (size_t)l * NC * D, 0, p.in[8] + l * D, scr, r, lane, true); continue; } r -= I_IN;
            if (r < I_OUT) { transpose_item(p.in[21] + (size_t)l * D * D, D, D, WOUT + (size_t)l * D * D, 0, nullptr, scr, r, lane); continue; } r -= I_OUT;
            if (r < I_MEM) { transpose_item(p.in[19] + (size_t)l * D * 256, D, 256, WMEM, l * 512, p.in[18] + l * D, scr, r, lane); continue; } r -= I_MEM;
            transpose_item(p.in[20] + (size_t)l * D * 256, D, 256, WMEM, l * 512 + 256, p.in[18] + l * D, scr, r, lane);
        }
        for (int m0 = gw; m0 < M; m0 += 4 * NGW) {
            f32x4 v[4][4]; float ss[4];
#pragma unroll
            for (int u = 0; u < 4; ++u) {
                const int m = m0 + u * NGW;
                const float* xr = m < NPR ? xp + (size_t)m * D : xs + (size_t)(m - NPR) * D;
#pragma unroll
                for (int j = 0; j < 4; ++j) v[u][j] = (m < M) ? __builtin_nontemporal_load((const f32x4*)xr + lane + 64 * j) : (f32x4){0.f, 0.f, 0.f, 0.f};
            }
#pragma unroll
            for (int u = 0; u < 4; ++u) {
                float a = 0.f;
#pragma unroll
                for (int j = 0; j < 4; ++j) a += (v[u][j].x * v[u][j].x + v[u][j].y * v[u][j].y) + (v[u][j].z * v[u][j].z + v[u][j].w * v[u][j].w);
                ss[u] = wave_sum(a);
            }
#pragma unroll
            for (int u = 0; u < 4; ++u) {
                const int m = m0 + u * NGW;
                if (m < M) {
                    v2u* o8 = (v2u*)(XB + (size_t)m * D) + lane;
#pragma unroll
                    for (int j = 0; j < 4; ++j) { v2u w; w.x = cvtpk(v[u][j].x, v[u][j].y); w.y = cvtpk(v[u][j].z, v[u][j].w); o8[64 * j] = w; }
                    if (lane < 16) SSPA[(size_t)m * 16 + lane] = (lane == 0) ? ss[u] : 0.f;
                }
            }
        }
        for (int m = gw; m < 1024; m += NGW) {
            const float ss = row_to_bf16(p.in[2] + (size_t)m * D, MNB + (size_t)m * D, lane);
            if (lane == 0) RSM[m] = rsqrtf(ss * (1.f / 1024.f) + EPS);
        }
        for (int i8 = bx * 512 + tid; i8 < 2 * 32 * 65536 / 8; i8 += G * 512) {
            const size_t i = (size_t)i8 * 8; const int l = (int)(i >> 21), b = (int)((i >> 16) & 31), mem = (int)((i >> 8) & 255), h = (int)((i >> 6) & 3), d = (int)(i & 63);
            const f32x4 a = *(const f32x4*)(p.in[6] + i), c = *(const f32x4*)(p.in[6] + i + 4);
            v4u o; o.x = cvtpk(a.x, a.y); o.y = cvtpk(a.z, a.w); o.z = cvtpk(c.x, c.y); o.w = cvtpk(c.z, c.w);
            const int mt = (mem >> 5) * 2 + ((mem >> 2) & 1), r = ((mem >> 3) & 3) * 4 + (mem & 3), kk = d >> 5, q = (d >> 3) & 3;
            *(v4u*)(W_KB + ((size_t)((l * NSEQ + 4 + b) * 4 + h) * 32 + mt * 2 + kk) * 512 + (q * 16 + r) * 8) = o;
        }
        for (int it = gw; it < 8192; it += NGW) {
            const int mg = it & 31, h = (it >> 5) & 3, b = (it >> 7) & 31, l = it >> 12;
            float f[8];
#pragma unroll
            for (int i = 0; i < 8; ++i) f[i] = p.in[7][(((size_t)(l * 32 + b) * 256 + mg * 8 + i) * 4 + h) * 64 + lane];
            const int mp = mg >> 2, q = mg & 3, dt = lane >> 4, r = lane & 15;
            *(v4u*)(W_VT + ((size_t)((l * NSEQ + 4 + b) * 4 + h) * 32 + mp * 4 + dt) * 512 + (q * 16 + r) * 8) = pack8(f);
        }
        for (int i = bx * 512 + tid; i < 32768; i += G * 512) {
            const int c = i & 63, e = (i >> 6) & 63, lg = i >> 12;
            W_PWT[i] = (bf16)(cvtpk(p.in[15][((size_t)lg * 64 + c) * 64 + e], 0.f) & 0xffffu);
        }
    }
    grid.sync();

    {
        PHASE_WS
        pg8::Gemm g{MNB, WMEM, 1024, 1024, D}; pg8::StaticOrder S; S.init(1024, 1024, G, G - 1 - bx);
        EpiKV E{RSM, p.out, W_KB, W_VT};
        pg8::gemm_phase<EpiKV, pg8::StaticOrder, false, true>(lds, g, S, E);
    }

    for (int l = 0; l < 2; ++l) {
        {
            PHASE_WS
            pg8::Gemm g{XB, WIN + (size_t)l * NC * D, M, NC, D}; pg8::StaticOrder S; S.init(M, NC, G, bx);
            EpiU E{UB, l == 0 ? SSPA : SSPB};
            pg8::gemm_phase<EpiU, pg8::StaticOrder, true, true>(lds, g, S, E);
        }
        xcd_barrier(bar);
        {
            PHASE_WS
            Lay L;
            L.U = UB; L.Y = YB; L.KB = W_KB + (size_t)l * NSEQ * 65536; L.VT = W_VT + (size_t)l * NSEQ * 65536; L.PWT = W_PWT + (size_t)l * 16384;
            L.caw = p.in[10] + l * 768; L.cbw = p.in[11] + l * 31 * 256; L.cbb = p.in[12] + l * 256; L.lng = p.in[13] + l * 256; L.lnb = p.in[14] + l * 256;
            L.pbias = p.in[16] + l * 256; L.pscale = p.in[17] + l * 256;
            L.sta = p.in[3] + (size_t)l * 32 * 2 * 256; L.stb = p.in[4] + (size_t)l * 32 * 30 * 256; L.stp = p.in[5] + (size_t)l * 32 * 15 * 256;
            L.out = p.out; L.l = l;
            const int nk = (5 * NTILE - bx + G - 1) / G;
            for (int kk = 0; kk < nk; ++kk) {
                int k2 = kk + (bx >> 3) % nk; if (k2 >= nk) k2 -= nk;
                const int idx = bx + k2 * G;
                const int grp = idx / NTILE; const Tile T = mk_tile(idx % NTILE); const int hp = grp - 2;
                if (grp == 0) mix_b(L, T, tid, lds);
                else if (grp == 1) mix_c(L, T, tid, lds);
                else if (grp < 4) mix_x(L, T, hp, tid, lds);
                else mix_a(L, T, tid);
            }
        }
        xcd_barrier(bar);
        {
            PHASE_WS
            pg8::Gemm g{YB, WOUT + (size_t)l * D * D, M, D, D}; pg8::StaticOrder S; S.init(M, D, G, bx);
            EpiX E{XB, l == 0 ? SSPB : SSPA, XB};
            pg8::gemm_phase<EpiX, pg8::StaticOrder, true, true>(lds, g, S, E);
        }
        xcd_barrier(bar);
    }
    {
        PHASE_WS
        const int gw = bx * 8 + wave, NGW = G * 8;
        const float* gf = p.in[22];
        f32x4 gv[4];
#pragma unroll
        for (int j = 0; j < 4; ++j) gv[j] = ((const f32x4*)gf)[lane + 64 * j];
        for (int m = gw; m < M; m += NGW) {
            const f32x4* sp = (const f32x4*)(SSPA + (size_t)m * 16);
            const f32x4 s0 = sp[0], s1 = sp[1], s2 = sp[2], s3 = sp[3];
            const float ss = ((s0.x + s0.y) + (s0.z + s0.w)) + ((s1.x + s1.y) + (s1.z + s1.w)) + ((s2.x + s2.y) + (s2.z + s2.w)) + ((s3.x + s3.y) + (s3.z + s3.w));
            const float rstd = rsqrtf(ss * (1.f / 1024.f) + EPS);
            const v2u* xr = (const v2u*)(XB + (size_t)m * D) + lane;
            f32x4* yr = (f32x4*)(p.out + (size_t)m * D) + lane;
            v2u xv[4];
#pragma unroll
            for (int j = 0; j < 4; ++j) xv[j] = __builtin_nontemporal_load(xr + 64 * j);
#pragma unroll
            for (int j = 0; j < 4; ++j) { const f32x4 v = (f32x4){bflo(xv[j].x), bfhi(xv[j].x), bflo(xv[j].y), bfhi(xv[j].y)}; __builtin_nontemporal_store(v * rstd * gv[j], yr + 64 * j); }
        }
    }
}

extern "C" void kernel_launch(void* const* d_in, const int* in_sizes, int n_in, void* d_out, int out_size, void* d_ws, size_t ws_size, hipStream_t stream) {
    static int grid_blocks = 0;
    if (grid_blocks == 0) {
        if (n_in != 23 || (size_t)out_size != O_END || ws_size < WS_END) { fprintf(stderr, "kernel_launch: unexpected shapes (n_in %d out %d ws %zu)\n", n_in, out_size, ws_size); grid_blocks = -1; return; }
        int dev = 0, cus = 0, per_cu = 0;
        hipGetDevice(&dev);
        hipDeviceGetAttribute(&cus, hipDeviceAttributeMultiprocessorCount, dev);
        if (hipFuncSetAttribute((const void*)hymba_fwd, hipFuncAttributeMaxDynamicSharedMemorySize, LDS_BYTES) != hipSuccess) { fprintf(stderr, "kernel_launch: hipFuncSetAttribute failed\n"); grid_blocks = -1; return; }
        if (hipOccupancyMaxActiveBlocksPerMultiprocessor(&per_cu, (const void*)hymba_fwd, 512, LDS_BYTES) != hipSuccess || per_cu < 1) { fprintf(stderr, "kernel_launch: occupancy query says %d\n", per_cu); per_cu = 1; }
        (void)hipGetLastError();
        grid_blocks = cus * 1;
    }
    if (grid_blocks < 0) return;
    Params p{};
    for (int i = 0; i < 23; ++i) p.in[i] = (const float*)d_in[i];
    p.out = (float*)d_out; p.ws = (unsigned char*)d_ws;
    if (hipMemsetAsync((char*)d_ws + WS_CTL, 0, 16384, stream) != hipSuccess) { fprintf(stderr, "kernel_launch: memset of barrier words failed\n"); return; }
    void* args[] = {&p};
    hipError_t e = hipLaunchCooperativeKernel((const void*)hymba_fwd, dim3(grid_blocks), dim3(512), args, LDS_BYTES, stream);
    if (e != hipSuccess) fprintf(stderr, "cooperative launch failed: %s (grid %d)\n", hipGetErrorString(e), grid_blocks);
}
```

```cpp
#include <hip/hip_runtime.h>
#include <hip/hip_cooperative_groups.h>
#include <cstdio>
#include <cstdint>
namespace cg = cooperative_groups;
namespace pg8 {
#define PG8_LAS __attribute__((address_space(3)))
typedef unsigned short bf16_t;
typedef short bf16x8 __attribute__((ext_vector_type(8)));
typedef float f32x4 __attribute__((ext_vector_type(4)));
typedef unsigned u32x4 __attribute__((ext_vector_type(4)));
constexpr int BM = 256, BK = 64, HALF = 128, HTB = HALF * BK * 2  , STAGE_BYTES = 8 * HTB, NXCD = 8, WGM = 8;

__host__ __device__ __forceinline__ int lds_byte(int r, int c) { const int st = (r >> 4) * 2 + (c >> 5), rr = r & 15, cc = c & 31, ob = rr * 64 + cc * 2; return st * 1024 + (ob ^ (((ob >> 9) & 1) << 5)); }
__host__ __device__ __forceinline__ void stage_rc(int b, int& R, int& C) { const int st = b / 1024, sb = b % 1024, swz = sb ^ (((sb >> 9) & 1) << 5); R = (st >> 1) * 16 + swz / 64; C = (st & 1) * 32 + (swz % 64) / 2; }
__host__ __device__ __forceinline__ int perm32(int rho) { const int n = rho >> 4, i = rho & 15; return 8 * (i >> 2) + 4 * n + (i & 3); }

struct Unit { int pm, pn; };
struct Gemm { const bf16_t* A; const bf16_t* Bt; int M, N, K; };

struct StaticOrder {
    int nM, nN, nwg, G, c;
    __host__ __device__ void init(int M, int N, int G_, int c_) { nM = M / BM; nN = N / BM; nwg = nM * nN; G = G_; c = c_; }
    __host__ __device__ bool next(int i, Unit& u) const {
        const long L = (long)i * G + c; if (L >= nwg) return false;
        int wgid = (int)L; { const int q = nwg / NXCD, r = nwg % NXCD, xcd = wgid % NXCD, off = wgid / NXCD; wgid = (xcd < r ? xcd * (q + 1) : r * (q + 1) + (xcd - r) * q) + off; }
        const int nig = WGM * nN, gid = wgid / nig, fm = gid * WGM, gsz = (nM - fm) < WGM ? (nM - fm) : WGM;
        u.pm = fm + ((wgid % nig) % gsz); u.pn = (wgid % nig) / gsz; return true;
    }
    __device__ __forceinline__ void a_ready(const Unit&) const {}
    __device__ __forceinline__ void done(const Unit&) const {}
};
__device__ __forceinline__ unsigned cvt_pk_bf16(float lo, float hi) { unsigned r; asm volatile("v_cvt_pk_bf16_f32 %0, %1, %2" : "=v"(r) : "v"(lo), "v"(hi)); return r; }
template <class Epi, class Sched, bool ALIGN_EPI = false, bool SP2 = false>
__device__ __forceinline__ void gemm_phase(PG8_LAS unsigned char* lds, const Gemm g, const Sched& S, const Epi& E) {
    const int tid = threadIdx.x, wid = __builtin_amdgcn_readfirstlane(tid >> 6), lane = tid & 63, wr = wid >> 2, wc = wid & 3, fr = lane & 15, fq = lane >> 4;
    const int K = g.K, nt = K / BK;
    unsigned voffA[2], voffB[2];
#pragma unroll
    for (int i = 0; i < 2; ++i) { int R, C; stage_rc(tid * 16 + i * 8192, R, C); const int Rb = Epi::PERM ? ((R & ~31) + perm32(R & 31)) : R;
        voffA[i] = (unsigned)(R * K + C) * 2u; voffB[i] = (unsigned)(Rb * K + C) * 2u; }
    const size_t kstep = (size_t)(BK * 2);
    const size_t hstep = (size_t)HALF * K * 2;
    const size_t tstep = 2 * hstep;
    const unsigned ldsw = (unsigned)wid * 1024u;
    const int aoff = lds_byte(wr * 64 + fr, fq * 8), boff = lds_byte(wc * 32 + fr, fq * 8);
#define PG8_SA(b, h) (((b) * 2 + (h)) * HTB)
#define PG8_SB(b, h) ((4 + (b) * 2 + (h)) * HTB)
#define PG8_STAGE(bufoff, gbase, voff) do { _Pragma("unroll") for (int _i = 0; _i < 2; ++_i) \
        __builtin_amdgcn_global_load_lds((const unsigned*)((const char*)(gbase) + (voff)[_i]), (PG8_LAS unsigned*)(lds + (bufoff) + ldsw + _i * 8192), 16, 0, 0); } while (0)
#define PG8_LDA(dst, b, h) do { _Pragma("unroll") for (int m = 0; m < 4; ++m) _Pragma("unroll") for (int k = 0; k < 2; ++k) dst[m][k] = *(const PG8_LAS bf16x8*)(lds + PG8_SA(b, h) + aoff + m * 2048 + k * 1024); } while (0)
#define PG8_LDB(dst, b, h) do { _Pragma("unroll") for (int n = 0; n < 2; ++n) _Pragma("unroll") for (int k = 0; k < 2; ++k) dst[n][k] = *(const PG8_LAS bf16x8*)(lds + PG8_SB(b, h) + boff + n * 2048 + k * 1024); } while (0)
#define PG8_MMA(ai, bj, At, Bt) do { __builtin_amdgcn_s_setprio(1); _Pragma("unroll") for (int m = 0; m < 4; ++m) _Pragma("unroll") for (int n = 0; n < 2; ++n) _Pragma("unroll") for (int k = 0; k < 2; ++k) \
        acc[ai][bj][m][n] = __builtin_amdgcn_mfma_f32_16x16x32_bf16(Bt[n][k], At[m][k], acc[ai][bj][m][n], 0, 0, 0); __builtin_amdgcn_s_setprio(0); } while (0)
#define PG8_WAIT_V(n) asm volatile("s_waitcnt vmcnt(" #n ")" ::: "memory")
#define PG8_WAIT_L(n) asm volatile("s_waitcnt lgkmcnt(" #n ")" ::: "memory")
#define PG8_BAR __builtin_amdgcn_s_barrier()
#define PG8_SCHED __builtin_amdgcn_sched_barrier(0)
    Unit cur, nxt; int ui = 0;
    if (!S.next(0, cur)) return;
    f32x4 acc[2][2][4][2];
#pragma unroll
    for (int a = 0; a < 2; ++a)
#pragma unroll
        for (int b = 0; b < 2; ++b)
#pragma unroll
            for (int m = 0; m < 4; ++m)
#pragma unroll
                for (int n = 0; n < 2; ++n) acc[a][b][m][n] = (f32x4){0.f, 0.f, 0.f, 0.f};
    bf16x8 At[4][2], B0[2][2], B1[2][2];
    const char* cA = (const char*)g.A + (size_t)cur.pm * tstep; const char* cB = (const char*)g.Bt + (size_t)cur.pn * tstep;
    S.a_ready(cur);
    if constexpr (SP2) {
        PG8_STAGE(PG8_SB(0, 0), cB, voffB); PG8_STAGE(PG8_SB(0, 1), cB + hstep, voffB); PG8_STAGE(PG8_SA(0, 0), cA, voffA); PG8_STAGE(PG8_SA(0, 1), cA + hstep, voffA);
        if (wr == 1) PG8_BAR;
        PG8_WAIT_V(2); PG8_BAR;
        PG8_STAGE(PG8_SB(1, 0), cB + kstep, voffB); PG8_STAGE(PG8_SA(1, 0), cA + kstep, voffA); PG8_STAGE(PG8_SB(1, 1), cB + hstep + kstep, voffB);
        PG8_WAIT_V(6); PG8_BAR;
    } else {
        PG8_STAGE(PG8_SB(0, 0), cB, voffB); PG8_STAGE(PG8_SA(0, 0), cA, voffA); PG8_STAGE(PG8_SB(0, 1), cB + hstep, voffB); PG8_STAGE(PG8_SA(0, 1), cA + hstep, voffA);
        if (wr == 1) PG8_BAR;
        PG8_WAIT_V(4); PG8_BAR;
        PG8_STAGE(PG8_SB(1, 0), cB + kstep, voffB); PG8_STAGE(PG8_SA(1, 0), cA + kstep, voffA); PG8_STAGE(PG8_SB(1, 1), cB + hstep + kstep, voffB);
        PG8_WAIT_V(6); PG8_BAR;
    }
    for (;;) {
        const bool has_next = S.next(ui + 1, nxt);
        const char* nA = has_next ? (const char*)g.A + (size_t)nxt.pm * tstep : cA; const char* nB = has_next ? (const char*)g.Bt + (size_t)nxt.pn * tstep : cB;
        for (int t = 0; t < nt; t += 2) {
            const bool last = (t == nt - 2);
            const char* a1 = cA + (size_t)(t + 1) * kstep;
            const char* a2 = last ? nA : cA + (size_t)(t + 2) * kstep; const char* b2 = last ? nB : cB + (size_t)(t + 2) * kstep;
            const char* a3 = a2 + kstep; const char* b3 = b2 + kstep;
            if (last && has_next) S.a_ready(nxt);
            if constexpr (SP2) {
            PG8_LDB(B0, 0, 0); PG8_LDB(B1, 0, 1); PG8_SCHED; PG8_LDA(At, 0, 0); PG8_STAGE(PG8_SA(1, 1), a1 + hstep, voffA);
            PG8_WAIT_V(8); PG8_WAIT_L(0); PG8_BAR; PG8_MMA(0, 0, At, B0); PG8_MMA(0, 1, At, B1); PG8_BAR; PG8_SCHED;
            PG8_LDA(At, 0, 1); PG8_STAGE(PG8_SB(0, 0), b2, voffB); PG8_STAGE(PG8_SB(0, 1), b2 + hstep, voffB); PG8_STAGE(PG8_SA(0, 0), a2, voffA);
            PG8_WAIT_V(8); PG8_WAIT_L(0); PG8_BAR; PG8_MMA(1, 0, At, B0); PG8_MMA(1, 1, At, B1); PG8_BAR; PG8_SCHED;
            PG8_LDB(B0, 1, 0); PG8_LDB(B1, 1, 1); PG8_SCHED; PG8_LDA(At, 1, 0); PG8_STAGE(PG8_SA(0, 1), a2 + hstep, voffA);
            PG8_WAIT_V(8); PG8_WAIT_L(0); PG8_BAR; PG8_MMA(0, 0, At, B0); PG8_MMA(0, 1, At, B1); PG8_BAR; PG8_SCHED;
            PG8_LDA(At, 1, 1); PG8_STAGE(PG8_SB(1, 0), b3, voffB); PG8_STAGE(PG8_SB(1, 1), b3 + hstep, voffB); PG8_STAGE(PG8_SA(1, 0), a3, voffA);
            PG8_WAIT_V(8); PG8_WAIT_L(0); PG8_BAR; PG8_MMA(1, 0, At, B0); PG8_MMA(1, 1, At, B1); PG8_BAR; PG8_SCHED;
            } else {
            PG8_LDB(B0, 0, 0); PG8_SCHED; PG8_LDA(At, 0, 0); PG8_STAGE(PG8_SA(1, 1), a1 + hstep, voffA);
            PG8_WAIT_L(8); PG8_BAR; PG8_WAIT_L(0); PG8_MMA(0, 0, At, B0); PG8_BAR; PG8_SCHED;
            PG8_LDB(B1, 0, 1); PG8_STAGE(PG8_SB(0, 0), b2, voffB);
            PG8_BAR; PG8_WAIT_L(0); PG8_MMA(0, 1, At, B1); PG8_BAR;
            PG8_LDA(At, 0, 1); PG8_STAGE(PG8_SA(0, 0), a2, voffA);
            PG8_BAR; PG8_WAIT_L(0); PG8_MMA(1, 0, At, B0); PG8_BAR; PG8_SCHED;
            PG8_STAGE(PG8_SB(0, 1), b2 + hstep, voffB);
            PG8_WAIT_V(6); PG8_BAR; PG8_MMA(1, 1, At, B1); PG8_BAR;
            PG8_LDB(B0, 1, 0); PG8_SCHED; PG8_LDA(At, 1, 0); PG8_STAGE(PG8_SA(0, 1), a2 + hstep, voffA);
            PG8_WAIT_L(8); PG8_BAR; PG8_WAIT_L(0); PG8_MMA(0, 0, At, B0); PG8_BAR; PG8_SCHED;
            PG8_LDB(B1, 1, 1); PG8_STAGE(PG8_SB(1, 0), b3, voffB);
            PG8_BAR; PG8_WAIT_L(0); PG8_MMA(0, 1, At, B1); PG8_BAR;
            PG8_LDA(At, 1, 1); PG8_STAGE(PG8_SA(1, 0), a3, voffA);
            PG8_BAR; PG8_WAIT_L(0); PG8_MMA(1, 0, At, B0); PG8_BAR; PG8_SCHED;
            PG8_STAGE(PG8_SB(1, 1), b3 + hstep, voffB);
            PG8_WAIT_V(6); PG8_BAR; PG8_MMA(1, 1, At, B1); PG8_BAR;
            }
        }
        if constexpr (ALIGN_EPI) { if (wr == 0) PG8_BAR; }
        if constexpr (!Epi::AFTER_DRAIN) { E(acc, cur, wr, wc, fr, fq); S.done(cur); }
        if (!has_next) break;
#pragma unroll
        for (int a = 0; a < 2; ++a)
#pragma unroll
            for (int b = 0; b < 2; ++b)
#pragma unroll
                for (int m = 0; m < 4; ++m)
#pragma unroll
                    for (int n = 0; n < 2; ++n) acc[a][b][m][n] = (f32x4){0.f, 0.f, 0.f, 0.f};
        cur = nxt; cA = nA; cB = nB; ++ui;
        if constexpr (ALIGN_EPI) { if (wr == 1) PG8_BAR; }
    }
    PG8_WAIT_V(0);
    if constexpr (!ALIGN_EPI) { if (wr == 0) PG8_BAR; }
    PG8_BAR;
    if constexpr (Epi::AFTER_DRAIN) { E.fused(acc, cur, wr, wc, fr, fq, lds, wid, lane); S.done(cur); }
#undef PG8_SA
#undef PG8_SB
#undef PG8_STAGE
#undef PG8_LDA
#undef PG8_LDB
#undef PG8_MMA
#undef PG8_WAIT_V
#undef PG8_WAIT_L
#undef PG8_BAR
#undef PG8_SCHED
}
}

#define LAS __attribute__((address_space(3)))
typedef unsigned short bf16;
typedef unsigned v4u __attribute__((ext_vector_type(4)));
typedef unsigned v2u __attribute__((ext_vector_type(2)));
typedef float f32x4 __attribute__((ext_vector_type(4)));
typedef short bf16x8 __attribute__((ext_vector_type(8)));

constexpr int D = 1024, NPR = 32768, NSR = 2048, M = NPR + NSR, NC = 2816, NSEQ = 36, NTILE = M / 64;
constexpr float EPS = 1e-6f;
constexpr size_t O_Y = 0, O_NAP = 35651584, O_NBP = O_NAP + 4096, O_NPP = O_NBP + 61440, O_MKP = O_NPP + 30720, O_MVP = O_MKP + 524288,
                 O_NAS = O_MVP + 524288, O_NBS = O_NAS + 32768, O_NPS = O_NBS + 491520, O_END = O_NPS + 245760;
constexpr size_t MiB = 1u << 20;
constexpr size_t WS_WIN = 0, WS_WOUT = 12 * MiB, WS_WMEM = 16 * MiB, WS_PWT = 18 * MiB, WS_RSM = 18 * MiB + 65536, WS_SSPA = 19 * MiB, WS_SSPB = 22 * MiB,
                 WS_CTL = 24 * MiB + 512 * 1024, WS_MNB = 25 * MiB, WS_KB = 28 * MiB, WS_VT = 38 * MiB, WS_XB = 48 * MiB, WS_Y = 116 * MiB, WS_U = 184 * MiB, WS_END = 372 * MiB;
constexpr int LDS_BYTES = 135168;

struct Params { const float* in[23]; float* out; unsigned char* ws; };

__device__ __forceinline__ unsigned cvtpk(float lo, float hi) { unsigned r; asm("v_cvt_pk_bf16_f32 %0, %1, %2" : "=v"(r) : "v"(lo), "v"(hi)); return r; }
__device__ __forceinline__ float bflo(unsigned u) { return __uint_as_float(u << 16); }
__device__ __forceinline__ float bfhi(unsigned u) { return __uint_as_float(u & 0xffff0000u); }
__device__ __forceinline__ float bf1(bf16 b) { return __uint_as_float(((unsigned)b) << 16); }
__device__ __forceinline__ float sigm(float x) { return __builtin_amdgcn_rcpf(1.f + __builtin_amdgcn_exp2f(-1.44269504f * x)); }
__device__ __forceinline__ float silu(float x) { return x * sigm(x); }
__device__ __forceinline__ void unpack8(v4u u, float (&f)[8]) { f[0] = bflo(u.x); f[1] = bfhi(u.x); f[2] = bflo(u.y); f[3] = bfhi(u.y); f[4] = bflo(u.z); f[5] = bfhi(u.z); f[6] = bflo(u.w); f[7] = bfhi(u.w); }
__device__ __forceinline__ v4u pack8(const float (&f)[8]) { v4u o; o.x = cvtpk(f[0], f[1]); o.y = cvtpk(f[2], f[3]); o.z = cvtpk(f[4], f[5]); o.w = cvtpk(f[6], f[7]); return o; }
__device__ __forceinline__ float wave_sum(float v) {
#pragma unroll
    for (int o = 1; o < 64; o <<= 1) v += __shfl_xor(v, o);
    return v;
}
#define LDS_WAIT() asm volatile("s_waitcnt lgkmcnt(0)" ::: "memory")

struct EpiU {
    static constexpr bool PERM = true, AFTER_DRAIN = false;
    bf16* U; const float* ssp;
    __device__ __forceinline__ void operator()(const f32x4 (&acc)[2][2][4][2], const pg8::Unit& u, int wr, int wc, int fr, int fq) const {
        const int row0 = u.pm * 256 + wr * 64 + fr, pn = u.pn, lc = wc * 32 + 8 * fq;
        float rs[2][4];
        {
            f32x4 sq[2][4];
#pragma unroll
            for (int ai = 0; ai < 2; ++ai)
#pragma unroll
                for (int m = 0; m < 4; ++m) sq[ai][m] = *(const f32x4*)(ssp + (size_t)(row0 + ai * 128 + m * 16) * 16 + fq * 4);
#pragma unroll
            for (int ai = 0; ai < 2; ++ai)
#pragma unroll
                for (int m = 0; m < 4; ++m) {
                    float t = (sq[ai][m].x + sq[ai][m].y) + (sq[ai][m].z + sq[ai][m].w);
                    t += __shfl_xor(t, 16); t += __shfl_xor(t, 32);
                    rs[ai][m] = rsqrtf(t * (1.0f / 1024.0f) + EPS);
                }
        }
#pragma unroll
        for (int ai = 0; ai < 2; ++ai)
#pragma unroll
            for (int m = 0; m < 4; ++m) {
                const int row = row0 + ai * 128 + m * 16;
                const float rstd = rs[ai][m];
                bf16* rowp = U + (size_t)row * 2048;
                if (pn < 6) {
                    const f32x4 a0 = acc[ai][0][m][0] * rstd, a1 = acc[ai][0][m][1] * rstd, g0 = acc[ai][1][m][0] * rstd, g1 = acc[ai][1][m][1] * rstd;
                    float o[8];
                    if ((pn >> 1) == 0) {
#pragma unroll
                        for (int j = 0; j < 4; ++j) { o[j] = a0[j] * silu(g0[j]); o[4 + j] = a1[j] * silu(g1[j]); }
                    } else if ((pn >> 1) == 1) {
#pragma unroll
                        for (int j = 0; j < 4; ++j) { o[j] = a0[j] * g0[j]; o[4 + j] = a1[j] * g1[j]; }
                    } else {
#pragma unroll
                        for (int j = 0; j < 4; ++j) { o[j] = a0[j] * sigm(g0[j]); o[4 + j] = a1[j] * sigm(g1[j]); }
                    }
                    *(v4u*)(rowp + (pn >> 1) * 256 + (pn & 1) * 128 + lc) = pack8(o);
                } else {
                    const float sc = (pn == 9) ? rstd * (0.125f * 1.44269504f) : rstd;
                    const bool act = (pn & 1) == 0;
#pragma unroll
                    for (int bj = 0; bj < 2; ++bj) {
                        const f32x4 v0 = acc[ai][bj][m][0] * sc, v1 = acc[ai][bj][m][1] * sc;
                        float o[8];
#pragma unroll
                        for (int j = 0; j < 4; ++j) { o[j] = act ? silu(v0[j]) : v0[j]; o[4 + j] = act ? silu(v1[j]) : v1[j]; }
                        *(v4u*)(rowp + 768 + (pn - 6) * 256 + bj * 128 + lc) = pack8(o);
                    }
                }
            }
    }
};
struct EpiX {
    static constexpr bool PERM = true, AFTER_DRAIN = false;
    bf16* XB; float* ssp; bf16* XO;
    __device__ __forceinline__ void operator()(const f32x4 (&acc)[2][2][4][2], const pg8::Unit& u, int wr, int wc, int fr, int fq) const {
        const int row0 = u.pm * 256 + wr * 64 + fr, col0 = u.pn * 256 + wc * 32 + 8 * fq;
#pragma unroll
        for (int ai = 0; ai < 2; ++ai) {
            v4u xv[4][2];
#pragma unroll
            for (int m = 0; m < 4; ++m)
#pragma unroll
                for (int bj = 0; bj < 2; ++bj) xv[m][bj] = *(const v4u*)(XB + (size_t)(row0 + ai * 128 + m * 16) * D + col0 + bj * 128);
#pragma unroll
            for (int m = 0; m < 4; ++m) {
                const int row = row0 + ai * 128 + m * 16;
                float ss = 0.f;
#pragma unroll
                for (int bj = 0; bj < 2; ++bj) {
                    float xo[8]; unpack8(xv[m][bj], xo);
                    const f32x4 a0 = acc[ai][bj][m][0], a1 = acc[ai][bj][m][1];
#pragma unroll
                    for (int j = 0; j < 4; ++j) { xo[j] += a0[j]; xo[4 + j] += a1[j]; }
#pragma unroll
                    for (int j = 0; j < 8; ++j) ss += xo[j] * xo[j];
                    *(v4u*)(XO + (size_t)row * D + col0 + bj * 128) = pack8(xo);
                }
                ss += __shfl_xor(ss, 16); ss += __shfl_xor(ss, 32);
                if (fq == 0) ssp[(size_t)row * 16 + u.pn * 4 + wc] = ss;
            }
        }
    }
};
struct EpiKV {
    static constexpr bool PERM = false, AFTER_DRAIN = true;
    const float* rsm; float* out; bf16* KB; bf16* VT;
    __device__ __forceinline__ void operator()(const f32x4 (&)[2][2][4][2], const pg8::Unit&, int, int, int, int) const {}
    __device__ __forceinline__ void fused(f32x4 (&acc)[2][2][4][2], const pg8::Unit& u, int wr, int wc, int fr, int fq, PG8_LAS unsigned char* lds, int wid, int lane) const {
        const int l = u.pn >> 1, isv = u.pn & 1, b = u.pm;
        const int mem0 = wr * 64 + fr, c0 = wc * 32 + 4 * fq;
        float* ob = out + O_MKP + (size_t)isv * (O_MVP - O_MKP) + (size_t)(l * 4 + b) * 65536;
        PG8_LAS bf16* img = (PG8_LAS bf16*)lds;
#pragma unroll
        for (int ai = 0; ai < 2; ++ai)
#pragma unroll
            for (int m = 0; m < 4; ++m) {
                const int mem = mem0 + ai * 128 + m * 16;
                const float rs = rsm[b * 256 + mem];
#pragma unroll
                for (int bj = 0; bj < 2; ++bj)
#pragma unroll
                    for (int n = 0; n < 2; ++n) {
                        const int c = c0 + bj * 128 + n * 16;
                        const f32x4 v = acc[ai][bj][m][n] * rs;
                        *(f32x4*)(ob + (size_t)mem * 256 + c) = v;
                        const int h = c >> 6, d = c & 63;
                        const unsigned w0 = cvtpk(v[0], v[1]), w1 = cvtpk(v[2], v[3]);
                        if (!isv) {
                            const int mt = (mem >> 5) * 2 + ((mem >> 2) & 1), r = ((mem >> 3) & 3) * 4 + (mem & 3), kk = d >> 5, q = (d >> 3) & 3, e = d & 7;
                            *(PG8_LAS v2u*)(img + ((h * 32 + mt * 2 + kk) * 512 + (q * 16 + r) * 8 + e)) = (v2u){w0, w1};
                        } else {
                            const int mp = mem >> 5, q = (mem >> 3) & 3, e = mem & 7, dt = d >> 4, r = d & 15;
                            PG8_LAS bf16* vp = img + ((h * 32 + mp * 4 + dt) * 512 + (q * 16 + r) * 8 + e);
                            vp[0] = (bf16)(w0 & 0xffffu); vp[8] = (bf16)(w0 >> 16); vp[16] = (bf16)(w1 & 0xffffu); vp[24] = (bf16)(w1 >> 16);
                        }
                    }
            }
        asm volatile("s_waitcnt lgkmcnt(0)" ::: "memory"); __builtin_amdgcn_s_barrier(); asm volatile("" ::: "memory");
        bf16* dst = KB + (ptrdiff_t)isv * (VT - KB) + (size_t)(l * NSEQ + b) * 65536;
        const int tid = wid * 64 + lane;
#pragma unroll
        for (int i = 0; i < 16; ++i) { const int ch = tid + 512 * i; *(v4u*)(dst + (size_t)ch * 8) = *(const PG8_LAS v4u*)(img + ch * 8); }
        asm volatile("s_waitcnt lgkmcnt(0)" ::: "memory"); __builtin_amdgcn_s_barrier(); asm volatile("" ::: "memory");
    }
};

__device__ __forceinline__ void transpose_item(const float* W, int K, int N, bf16* WT, int row_off, const float* gs, LAS float* scr, int item, int lane, bool remap = false) {
    const int nblk = N / 32, kb = item / nblk, nb = item % nblk, k0 = 64 * kb, n0 = 32 * nb;
    int d0 = n0;
    if (remap) { const int sp = n0 >> 8, ch = n0 & 255; if (sp < 6) { const int pair = (sp == 0 || sp == 3) ? 0 : ((sp == 1 || sp == 2) ? 1 : 2), bj = (sp == 3 || sp == 2 || sp == 5) ? 1 : 0; d0 = (pair * 2 + (ch >> 7)) * 256 + bj * 128 + (ch & 127); } }
    f32x4 tv[8];
#pragma unroll
    for (int i = 0; i < 8; ++i) { const int kk = 8 * i + (lane >> 3); tv[i] = *(const f32x4*)(W + (size_t)(k0 + kk) * N + n0 + (lane & 7) * 4); }
#pragma unroll
    for (int i = 0; i < 8; ++i) { const int kk = 8 * i + (lane >> 3); f32x4 v = tv[i]; if (gs) v = v * gs[k0 + kk];
        LAS float* d = scr + kk * 33 + (lane & 7) * 4; d[0] = v.x; d[1] = v.y; d[2] = v.z; d[3] = v.w; }
    LDS_WAIT();
    const int c = lane & 7;
#pragma unroll
    for (int j = 0; j < 4; ++j) { const int n = (lane >> 3) + 8 * j; const LAS float* s = scr + (8 * c) * 33 + n;
        v4u o; o.x = cvtpk(s[0 * 33], s[1 * 33]); o.y = cvtpk(s[2 * 33], s[3 * 33]); o.z = cvtpk(s[4 * 33], s[5 * 33]); o.w = cvtpk(s[6 * 33], s[7 * 33]);
        *(v4u*)(WT + (size_t)(row_off + d0 + n) * K + k0 + 8 * c) = o; }
    LDS_WAIT();
}
__device__ __forceinline__ float row_to_bf16(const float* xrow, bf16* orow, int lane) {
    const f32x4* xr = (const f32x4*)xrow + lane;
    f32x4 v[4]; float s = 0.f;
#pragma unroll
    for (int j = 0; j < 4; ++j) { v[j] = xr[64 * j]; s += (v[j].x * v[j].x + v[j].y * v[j].y) + (v[j].z * v[j].z + v[j].w * v[j].w); }
    s = wave_sum(s);
    v2u* o8 = (v2u*)orow + lane;
#pragma unroll
    for (int j = 0; j < 4; ++j) { v2u w; w.x = cvtpk(v[j].x, v[j].y); w.y = cvtpk(v[j].z, v[j].w); o8[64 * j] = w; }
    return s;
}

constexpr int UC = 2048, C_ABG = 0, C_V = 256, C_GLU = 512, C_SBG = 768, C_CU = 1024, C_SCG = 1280, C_Q = 1536, C_SXG = 1792;
struct Lay {
    const bf16* U; bf16* Y; const bf16* KB; const bf16* VT; const bf16* PWT;
    const float *caw, *cbw, *cbb, *lng, *lnb, *pbias, *pscale, *sta, *stb, *stp;
    float* out; int l;
};
struct Tile { int row0, seq, t0, first, last, samp, b; };
__device__ __forceinline__ Tile mk_tile(int tt) {
    Tile T; T.row0 = tt * 64;
    if (tt < 512) { T.seq = tt >> 7; T.t0 = (tt & 127) * 64; T.first = (tt & 127) == 0; T.last = (tt & 127) == 127; T.samp = 0; T.b = T.seq; }
    else { T.seq = 4 + (tt - 512); T.t0 = 0; T.first = 1; T.last = 1; T.samp = 1; T.b = tt - 512; }
    return T;
}
__device__ __forceinline__ void ld8f(const float* s, float (&f)[8]) { const f32x4 a = *(const f32x4*)s, b = *(const f32x4*)(s + 4); f[0] = a.x; f[1] = a.y; f[2] = a.z; f[3] = a.w; f[4] = b.x; f[5] = b.y; f[6] = b.z; f[7] = b.w; }

__device__ __forceinline__ void mix_a(const Lay& L, const Tile& T, int tid) {
    asm volatile("" : "+v"(tid));
    const int c0 = (tid & 31) * 8, tq = tid >> 5;
    const bf16* ub = L.U + (size_t)(T.row0 + tq * 4) * UC + c0;
    const bool hist = T.first && tq == 0;
    v4u rv[6], rb[4];
#pragma unroll
    for (int jj = 0; jj < 6; ++jj) rv[jj] = (jj >= 2 || !hist) ? __builtin_nontemporal_load((const v4u*)(ub + (jj - 2) * UC + C_V)) : (v4u){0u, 0u, 0u, 0u};
#pragma unroll
    for (int j = 0; j < 4; ++j) rb[j] = __builtin_nontemporal_load((const v4u*)(ub + j * UC + C_ABG));
    float w[3][8];
#pragma unroll
    for (int k = 0; k < 3; ++k) ld8f(L.caw + k * 256 + c0, w[k]);
    float v[6][8];
#pragma unroll
    for (int jj = 0; jj < 6; ++jj) unpack8(rv[jj], v[jj]);
    if (hist && T.samp) { ld8f(L.sta + ((size_t)T.b * 2 + 0) * 256 + c0, v[0]); ld8f(L.sta + ((size_t)T.b * 2 + 1) * 256 + c0, v[1]); }
#pragma unroll
    for (int j = 0; j < 4; ++j) {
        float fb[8], y[8]; unpack8(rb[j], fb);
#pragma unroll
        for (int i = 0; i < 8; ++i) y[i] = fb[i] * (w[0][i] * v[j][i] + w[1][i] * v[j + 1][i] + w[2][i] * v[j + 2][i]);
        *(v4u*)(L.Y + (size_t)(T.row0 + tq * 4 + j) * D + c0) = pack8(y);
    }
    if (T.last && tq == 15) {
#pragma unroll
        for (int j2 = 0; j2 < 2; ++j2) {
            float* dst = L.out + (T.samp ? O_NAS + ((size_t)(L.l * 32 + T.b) * 2 + j2) * 256 : O_NAP + ((size_t)(L.l * 4 + T.b) * 2 + j2) * 256) + c0;
            *(f32x4*)dst = (f32x4){v[4 + j2][0], v[4 + j2][1], v[4 + j2][2], v[4 + j2][3]};
            *(f32x4*)(dst + 4) = (f32x4){v[4 + j2][4], v[4 + j2][5], v[4 + j2][6], v[4 + j2][7]};
        }
    }
}

__device__ __forceinline__ void mix_b(const Lay& L, const Tile& T, int tid, LAS unsigned char* lds) {
    asm volatile("" : "+v"(tid));
    LAS float* G = (LAS float*)lds;
    LAS float* red = (LAS float*)(lds + 98304);
    LAS bf16* SB = (LAS bf16*)(lds + 100352);
    LAS float* stat = (LAS float*)(lds + 133632);
    const int c = tid & 255, th = tid >> 8, lane = tid & 63, wq = (tid >> 6) & 3;
    float w[31];
    {
        v4u rg[6], rs[4];
#pragma unroll
        for (int k = 0; k < 6; ++k) {
            const int i = tid + 512 * k, r = i >> 5, c0 = (i & 31) * 8, tt = r - 30;
            rg[k] = (i < 94 * 32 && (tt >= 0 || !T.first)) ? __builtin_nontemporal_load((const v4u*)(L.U + (size_t)(T.row0 + tt) * UC + C_GLU + c0)) : (v4u){0u, 0u, 0u, 0u};
        }
#pragma unroll
        for (int k = 0; k < 4; ++k) { const int i = tid + 512 * k, r = i >> 5, c0 = (i & 31) * 8; rs[k] = __builtin_nontemporal_load((const v4u*)(L.U + (size_t)(T.row0 + r) * UC + C_SBG + c0)); }
#pragma unroll
        for (int k = 0; k < 31; ++k) w[k] = L.cbw[k * 256 + c];
#pragma unroll
        for (int k = 0; k < 6; ++k) {
            const int i = tid + 512 * k, r = i >> 5, c0 = (i & 31) * 8, tt = r - 30;
            if (i < 94 * 32) {
                float g8[8]; unpack8(rg[k], g8);
                if (tt < 0 && T.first && T.samp) ld8f(L.stb + ((size_t)T.b * 30 + r) * 256 + c0, g8);
                *(LAS f32x4*)(G + r * 256 + c0) = (f32x4){g8[0], g8[1], g8[2], g8[3]};
                *(LAS f32x4*)(G + r * 256 + c0 + 4) = (f32x4){g8[4], g8[5], g8[6], g8[7]};
            }
        }
#pragma unroll
        for (int k = 0; k < 4; ++k) { const int i = tid + 512 * k; *(LAS v4u*)(SB + i * 8) = rs[k]; }
    }
    __syncthreads();
    const float bias = L.cbb[c];
    float z[4][8];
    {
        float g[62];
#pragma unroll
        for (int i = 0; i < 62; ++i) g[i] = G[(th * 32 + i) * 256 + c];
#pragma unroll
        for (int ch = 0; ch < 4; ++ch)
#pragma unroll
            for (int j = 0; j < 8; ++j) {
                float a = bias;
#pragma unroll
                for (int k = 0; k < 31; ++k) a += w[k] * g[ch * 8 + j + k];
                z[ch][j] = a;
            }
    }
    const bool b5 = (lane & 32) != 0, b4 = (lane & 16) != 0, b3 = (lane & 8) != 0;
#pragma unroll
    for (int ch = 0; ch < 4; ++ch) {
        const int tb = th * 32 + ch * 8;
        float r1[4], r2[4];
#pragma unroll
        for (int i = 0; i < 4; ++i) {
            const float za = z[ch][i], zb = z[ch][4 + i];
            const float k1 = b5 ? zb : za, s1 = b5 ? za : zb;
            r1[i] = k1 + __shfl_xor(s1, 32);
            const float k2 = b5 ? zb * zb : za * za, s2 = b5 ? za * za : zb * zb;
            r2[i] = k2 + __shfl_xor(s2, 32);
        }
        float q1[2], q2[2];
#pragma unroll
        for (int i = 0; i < 2; ++i) {
            const float k1 = b4 ? r1[2 + i] : r1[i], s1 = b4 ? r1[i] : r1[2 + i];
            q1[i] = k1 + __shfl_xor(s1, 16);
            const float k2 = b4 ? r2[2 + i] : r2[i], s2 = b4 ? r2[i] : r2[2 + i];
            q2[i] = k2 + __shfl_xor(s2, 16);
        }
        float d1 = (b3 ? q1[1] : q1[0]) + __shfl_xor(b3 ? q1[0] : q1[1], 8);
        float d2 = (b3 ? q2[1] : q2[0]) + __shfl_xor(b3 ? q2[0] : q2[1], 8);
        d1 += __shfl_xor(d1, 4); d1 += __shfl_xor(d1, 2); d1 += __shfl_xor(d1, 1);
        d2 += __shfl_xor(d2, 4); d2 += __shfl_xor(d2, 2); d2 += __shfl_xor(d2, 1);
        if ((lane & 7) == 0) { red[(tb + (lane >> 3)) * 8 + wq * 2] = d1; red[(tb + (lane >> 3)) * 8 + wq * 2 + 1] = d2; }
    }
    __syncthreads();
    if (T.last) {
        float* dst = L.out + (T.samp ? O_NBS + (size_t)(L.l * 32 + T.b) * 30 * 256 : O_NBP + (size_t)(L.l * 4 + T.b) * 30 * 256);
        for (int i = tid; i < 30 * 256; i += 512) dst[i] = G[64 * 256 + i];
    }
    if (tid < 64) {
        const f32x4 ra = *(LAS f32x4*)(red + tid * 8), rb = *(LAS f32x4*)(red + tid * 8 + 4);
        const float S1 = (ra.x + ra.z) + (rb.x + rb.z), S2 = (ra.y + ra.w) + (rb.y + rb.w);
        const float mu = S1 * (1.f / 256.f), var = S2 * (1.f / 256.f) - mu * mu;
        stat[tid * 2] = mu; stat[tid * 2 + 1] = rsqrtf(fmaxf(var, 0.f) + EPS);
    }
    const float lg = L.lng[c], lb = L.lnb[c];
    __syncthreads();
    {
        typedef float f32x2v __attribute__((ext_vector_type(2)));
        f32x2v st[4][8]; float gt[4][8];
#pragma unroll
        for (int ch = 0; ch < 4; ++ch)
#pragma unroll
            for (int j = 0; j < 8; ++j) { const int t = th * 32 + ch * 8 + j; st[ch][j] = *(const LAS f32x2v*)(stat + t * 2); gt[ch][j] = bf1(SB[t * 256 + c]); }
#pragma unroll
        for (int ch = 0; ch < 4; ++ch)
#pragma unroll
            for (int j = 0; j < 8; ++j) {
                const float zn = (z[ch][j] - st[ch][j].x) * (st[ch][j].y * lg) + lb;
                gt[ch][j] = silu(zn) * gt[ch][j];
            }
#pragma unroll
        for (int ch = 0; ch < 4; ++ch)
#pragma unroll
            for (int j = 0; j < 8; ++j) { const int t = th * 32 + ch * 8 + j; SB[t * 256 + c] = (bf16)(cvtpk(gt[ch][j], 0.f) & 0xffffu); }
    }
    __syncthreads();
#pragma unroll
    for (int k = 0; k < 4; ++k) { const int i = tid + 512 * k, r = i >> 5, c0 = (i & 31) * 8; *(v4u*)(L.Y + (size_t)(T.row0 + r) * D + 256 + c0) = *(LAS v4u*)(SB + i * 8); }
    __syncthreads();
}

__device__ __forceinline__ void mix_c(const Lay& L, const Tile& T, int tid, LAS unsigned char* lds) {
    asm volatile("" : "+v"(tid));
    LAS float* P = (LAS float*)lds;
    LAS bf16* Dm = (LAS bf16*)(lds + 81920);
    const int wave = tid >> 6, lane = tid & 63, mg = wave & 3, mth = wave >> 2, mr = lane & 15, mq = lane >> 4;
    v2u cg2[4][2];
    bf16x8 af[4][2];
    {
        v4u rg[5];
#pragma unroll
        for (int k = 0; k < 5; ++k) {
            const int i = tid + 512 * k, r = i >> 5, c0 = (i & 31) * 8, tt = r - 15;
            rg[k] = (i < 79 * 32 && (tt >= 0 || !T.first)) ? __builtin_nontemporal_load((const v4u*)(L.U + (size_t)(T.row0 + tt) * UC + C_CU + c0)) : (v4u){0u, 0u, 0u, 0u};
        }
#pragma unroll
        for (int mt = 0; mt < 4; ++mt)
#pragma unroll
            for (int nt = 0; nt < 2; ++nt) cg2[mt][nt] = *(const v2u*)(L.U + (size_t)(T.row0 + mth * 32 + nt * 16 + mr) * UC + C_SCG + mg * 64 + mt * 16 + 4 * mq);
#pragma unroll
        for (int mt = 0; mt < 4; ++mt)
#pragma unroll
            for (int kk = 0; kk < 2; ++kk) af[mt][kk] = *(const bf16x8*)(L.PWT + ((size_t)(mg * 64 + mt * 16 + mr)) * 64 + kk * 32 + mq * 8);
#pragma unroll
        for (int k = 0; k < 5; ++k) {
            const int i = tid + 512 * k, r = i >> 5, c0 = (i & 31) * 8, tt = r - 15;
            if (i < 79 * 32) {
                float g8[8]; unpack8(rg[k], g8);
                if (tt < 0 && T.first && T.samp) ld8f(L.stp + ((size_t)T.b * 15 + r) * 256 + c0, g8);
                *(LAS f32x4*)(P + r * 256 + c0) = (f32x4){g8[0], g8[1], g8[2], g8[3]};
                *(LAS f32x4*)(P + r * 256 + c0 + 4) = (f32x4){g8[4], g8[5], g8[6], g8[7]};
            }
        }
    }
    __syncthreads();
    {
        const int c = tid & 255, th = tid >> 8, g = __builtin_amdgcn_readfirstlane(c >> 6), w = 2 << g;
        const LAS float* Pc = P + th * 32 * 256 + c;
        float x[47], cur[32];
#pragma unroll
        for (int i = 0; i < 47; ++i) x[i] = Pc[i * 256];
#pragma unroll
        for (int i = 0; i < 32; ++i) cur[i] = x[15 + i];
#pragma unroll
        for (int i = 46; i >= 1; --i) x[i] += x[i - 1];
        if (g >= 1) {
#pragma unroll
            for (int i = 46; i >= 3; --i) x[i] += x[i - 2];
        }
        if (g >= 2) {
#pragma unroll
            for (int i = 46; i >= 7; --i) x[i] += x[i - 4];
        }
        if (g >= 3) {
#pragma unroll
            for (int i = 46; i >= 15; --i) x[i] += x[i - 8];
        }
        const int pos1 = (T.samp ? 1024 : 0) + T.t0 + th * 32 + 1;
        const float rw = __builtin_amdgcn_rcpf((float)w);
#pragma unroll
        for (int i = 0; i < 32; ++i) {
            const float rc = (pos1 + i >= w) ? rw : __builtin_amdgcn_rcpf((float)(pos1 + i));
            const float d = x[15 + i] * rc - cur[i];
            Dm[(th * 32 + i) * 264 + c] = (bf16)(cvtpk(d, 0.f) & 0xffffu);
        }
    }
    __syncthreads();
    if (T.last) {
        float* dst = L.out + (T.samp ? O_NPS + (size_t)(L.l * 32 + T.b) * 15 * 256 : O_NPP + (size_t)(L.l * 4 + T.b) * 15 * 256);
        for (int i = tid; i < 15 * 256; i += 512) dst[i] = P[64 * 256 + i];
    }
    {
        bf16x8 bfr[2][2];
#pragma unroll
        for (int nt = 0; nt < 2; ++nt)
#pragma unroll
            for (int kk = 0; kk < 2; ++kk) bfr[nt][kk] = *(const LAS bf16x8*)(Dm + (mth * 32 + nt * 16 + mr) * 264 + mg * 64 + kk * 32 + mq * 8);
        f32x4 acc[4][2];
#pragma unroll
        for (int mt = 0; mt < 4; ++mt)
#pragma unroll
            for (int nt = 0; nt < 2; ++nt) {
                f32x4 a = (f32x4){0.f, 0.f, 0.f, 0.f};
                a = __builtin_amdgcn_mfma_f32_16x16x32_bf16(af[mt][0], bfr[nt][0], a, 0, 0, 0);
                a = __builtin_amdgcn_mfma_f32_16x16x32_bf16(af[mt][1], bfr[nt][1], a, 0, 0, 0);
                acc[mt][nt] = a;
            }
#pragma unroll
        for (int mt = 0; mt < 4; ++mt) {
            const int chn = mg * 64 + mt * 16 + 4 * mq;
            const f32x4 pb = *(const f32x4*)(L.pbias + chn), ps = *(const f32x4*)(L.pscale + chn);
#pragma unroll
            for (int nt = 0; nt < 2; ++nt) {
                const size_t row = (size_t)(T.row0 + mth * 32 + nt * 16 + mr);
                const float y0 = (acc[mt][nt][0] + pb.x) * ps.x * bflo(cg2[mt][nt].x), y1 = (acc[mt][nt][1] + pb.y) * ps.y * bfhi(cg2[mt][nt].x);
                const float y2 = (acc[mt][nt][2] + pb.z) * ps.z * bflo(cg2[mt][nt].y), y3 = (acc[mt][nt][3] + pb.w) * ps.w * bfhi(cg2[mt][nt].y);
                v2u o; o.x = cvtpk(y0, y1); o.y = cvtpk(y2, y3);
                *(v2u*)(L.Y + row * D + 512 + chn) = o;
            }
        }
    }
    __syncthreads();
}

__device__ __forceinline__ void mix_x(const Lay& L, const Tile& T, int hp, int tid, LAS unsigned char* lds) {
    asm volatile("" : "+v"(tid));
    const int wave = __builtin_amdgcn_readfirstlane(tid >> 6), lane = tid & 63, hl = wave >> 2, h = hp * 2 + hl, nt = wave & 3, r = lane & 15, q = lane >> 4;
    {
        const char* ksrc = (const char*)(L.KB + ((size_t)T.seq * 4 + hp * 2) * 16384);
        const char* vsrc = (const char*)(L.VT + ((size_t)T.seq * 4 + hp * 2) * 16384);
#pragma unroll
        for (int i = 0; i < 8; ++i) {
            const int cb = i * 8 + wave;
            const int dst = (cb >> 5) * 65536 + (cb & 31) * 1024;
            __builtin_amdgcn_global_load_lds((const unsigned*)(ksrc + (size_t)cb * 1024 + lane * 16), (LAS unsigned*)(lds + dst), 16, 0, 0);
            __builtin_amdgcn_global_load_lds((const unsigned*)(vsrc + (size_t)cb * 1024 + lane * 16), (LAS unsigned*)(lds + dst + 32768), 16, 0, 0);
        }
    }
    const size_t row = (size_t)(T.row0 + nt * 16 + r);
    bf16x8 qf[2];
#pragma unroll
    for (int kk = 0; kk < 2; ++kk) qf[kk] = *(const bf16x8*)(L.U + row * UC + C_Q + h * 64 + kk * 32 + q * 8);
    v2u xg[4];
#pragma unroll
    for (int dt = 0; dt < 4; ++dt) xg[dt] = *(const v2u*)(L.U + row * UC + C_SXG + h * 64 + dt * 16 + 4 * q);
    asm volatile("s_waitcnt vmcnt(0)" ::: "memory");
    __syncthreads();
    const LAS bf16x8* Kf = (const LAS bf16x8*)(lds + hl * 65536) + lane;
    const LAS bf16x8* Vf = (const LAS bf16x8*)(lds + hl * 65536 + 32768) + lane;
    f32x4 s[16];
#pragma unroll
    for (int mt = 0; mt < 16; ++mt) {
        const bf16x8 k0 = Kf[(mt * 2) * 64], k1 = Kf[(mt * 2 + 1) * 64];
        f32x4 a = (f32x4){0.f, 0.f, 0.f, 0.f};
        a = __builtin_amdgcn_mfma_f32_16x16x32_bf16(k0, qf[0], a, 0, 0, 0);
        a = __builtin_amdgcn_mfma_f32_16x16x32_bf16(k1, qf[1], a, 0, 0, 0);
        s[mt] = a;
    }
    float mx = -3.0e38f;
#pragma unroll
    for (int mt = 0; mt < 16; ++mt) mx = fmaxf(mx, fmaxf(fmaxf(s[mt][0], s[mt][1]), fmaxf(s[mt][2], s[mt][3])));
    mx = fmaxf(mx, __shfl_xor(mx, 16)); mx = fmaxf(mx, __shfl_xor(mx, 32));
    float sum = 0.f;
#pragma unroll
    for (int mt = 0; mt < 16; ++mt)
#pragma unroll
        for (int j = 0; j < 4; ++j) { const float pv = __builtin_amdgcn_exp2f(s[mt][j] - mx); s[mt][j] = pv; sum += pv; }
    sum += __shfl_xor(sum, 16); sum += __shfl_xor(sum, 32);
    const float inv = 1.0f / sum;
    f32x4 o[4];
#pragma unroll
    for (int dt = 0; dt < 4; ++dt) o[dt] = (f32x4){0.f, 0.f, 0.f, 0.f};
#pragma unroll
    for (int mp = 0; mp < 8; ++mp) {
        v4u pk; pk.x = cvtpk(s[2 * mp][0], s[2 * mp][1]); pk.y = cvtpk(s[2 * mp][2], s[2 * mp][3]);
        pk.z = cvtpk(s[2 * mp + 1][0], s[2 * mp + 1][1]); pk.w = cvtpk(s[2 * mp + 1][2], s[2 * mp + 1][3]);
        const bf16x8 pf = __builtin_bit_cast(bf16x8, pk);
#pragma unroll
        for (int dt = 0; dt < 4; ++dt) o[dt] = __builtin_amdgcn_mfma_f32_16x16x32_bf16(Vf[(mp * 4 + dt) * 64], pf, o[dt], 0, 0, 0);
    }
#pragma unroll
    for (int dt = 0; dt < 4; ++dt) {
        const float y0 = o[dt][0] * inv * bflo(xg[dt].x), y1 = o[dt][1] * inv * bfhi(xg[dt].x);
        const float y2 = o[dt][2] * inv * bflo(xg[dt].y), y3 = o[dt][3] * inv * bfhi(xg[dt].y);
        v2u ov; ov.x = cvtpk(y0, y1); ov.y = cvtpk(y2, y3);
        *(v2u*)(L.Y + row * D + 768 + h * 64 + dt * 16 + 4 * q) = ov;
    }
    __syncthreads();
}

#define XB_TMO      128
#define XB_XCNT(j)  (256  + 64 * (j))
#define XB_XSUB(j)  (1280 + 64 * (j))
#define XB_XGEN(j)  (2304 + 64 * (j))
#define XB_TOP      3328
#define XB_TOPGEN   3392
#define XCD_BAR_WORDS 3456
#define XB_SPIN_CAP (1u << 18)

__device__ __forceinline__ unsigned xb_ld(unsigned* p)              { return __hip_atomic_load(p, __ATOMIC_RELAXED, __HIP_MEMORY_SCOPE_AGENT); }
__device__ __forceinline__ unsigned xb_add(unsigned* p, unsigned v) { return __hip_atomic_fetch_add(p, v, __ATOMIC_RELAXED, __HIP_MEMORY_SCOPE_AGENT); }
__device__ __forceinline__ unsigned xb_xcc_id() { return (unsigned)__builtin_amdgcn_s_getreg((3 << 11) | 20) & 0xFu; }
#define XB_SPIN(cond, bar) do { unsigned _sp = 0; while (cond) { __builtin_amdgcn_s_sleep(1); \
    if ((++_sp & 255u) == 0u) { if (xb_ld(&(bar)[XB_TMO])) break; if (_sp > XB_SPIN_CAP) { atomicAdd(&(bar)[XB_TMO], 1u); break; } } } } while (0)

struct XcdBarrier {
    unsigned* bar; unsigned x;
    volatile LAS unsigned* st;
};

__device__ __forceinline__ XcdBarrier xcd_barrier_post(unsigned* bar, volatile LAS unsigned* st) {
    XcdBarrier b; b.bar = bar; b.x = xb_xcc_id(); b.st = st;
    if (threadIdx.x == 0) (void)xb_add(&bar[XB_XCNT(b.x)], 1u);
    return b;
}
__device__ __forceinline__ void xcd_barrier_complete(unsigned* bar, unsigned x, unsigned& nloc, unsigned& nx) {
    const unsigned G = gridDim.x * gridDim.y * gridDim.z;
    unsigned sum, cnt, mine, sp = 0u;
    for (;;) {
        sum = 0u; cnt = 0u; mine = 0u;
#pragma unroll
        for (unsigned j = 0; j < 16; ++j) { const unsigned c = xb_ld(&bar[XB_XCNT(j)]); sum += c; cnt += (c > 0u) ? 1u : 0u; mine = (j == x) ? c : mine; }
        if (sum == G) break;
        __builtin_amdgcn_s_sleep(1);
        if ((++sp & 255u) == 0u) { if (xb_ld(&bar[XB_TMO])) break; if (sp > XB_SPIN_CAP) { atomicAdd(&bar[XB_TMO], 1u); break; } }
    }
    nloc = mine > 0u ? mine : 1u; nx = cnt > 0u ? cnt : 1u;
}

__device__ __forceinline__ void xcd_barrier(const XcdBarrier& b) {
    asm volatile("s_waitcnt vmcnt(0)" ::: "memory");
    __syncthreads();
    if (threadIdx.x == 0) {
        unsigned* bar = b.bar;
        __builtin_amdgcn_s_waitcnt(0);
        unsigned nloc = b.st[0], nx = b.st[1];
        if (nloc == 0u) { xcd_barrier_complete(bar, b.x, nloc, nx); b.st[0] = nloc; b.st[1] = nx; }
        const unsigned old = xb_add(&bar[XB_XSUB(b.x)], 1u);
        const unsigned gen = old / nloc;
        if (old + 1u == (gen + 1u) * nloc) {
            __builtin_amdgcn_fence(__ATOMIC_RELEASE, "agent");
            asm volatile("s_waitcnt vmcnt(0)" ::: "memory");
            const unsigned og = xb_add(&bar[XB_TOP], 1u);
            const unsigned tg = og / nx;
            if (og + 1u == (tg + 1u) * nx) xb_add(&bar[XB_TOPGEN], 1u);
            else XB_SPIN(xb_ld(&bar[XB_TOPGEN]) == tg, bar);
            __builtin_amdgcn_fence(__ATOMIC_ACQUIRE, "agent");
            xb_add(&bar[XB_XGEN(b.x)], 1u);
            asm volatile("s_waitcnt vmcnt(0)" ::: "memory");
        } else {
            XB_SPIN(xb_ld(&bar[XB_XGEN(b.x)]) == gen, bar);
            __builtin_amdgcn_fence(__ATOMIC_ACQUIRE, "agent");
            asm volatile("s_waitcnt vmcnt(0)" ::: "memory");
        }
    }
    __syncthreads();
}

#define WIN ((bf16*)(ws + WS_WIN))
#define WOUT ((bf16*)(ws + WS_WOUT))
#define WMEM ((bf16*)(ws + WS_WMEM))
#define W_PWT ((bf16*)(ws + WS_PWT))
#define RSM ((float*)(ws + WS_RSM))
#define SSPA ((float*)(ws + WS_SSPA))
#define SSPB ((float*)(ws + WS_SSPB))
#define MNB ((bf16*)(ws + WS_MNB))
#define W_KB ((bf16*)(ws + WS_KB))
#define W_VT ((bf16*)(ws + WS_VT))
#define XB ((bf16*)(ws + WS_XB))
#define YB ((bf16*)(ws + WS_Y))
#define UB ((bf16*)(ws + WS_U))
#define PHASE_WS __attribute__((address_space(1))) unsigned char* wsg_ = (__attribute__((address_space(1))) unsigned char*)p.ws; asm volatile("" : "+s"(wsg_)); unsigned char* ws = (unsigned char*)wsg_;
__global__ void __launch_bounds__(512, 2) hymba_fwd(Params p) {
    extern __shared__ __attribute__((aligned(16))) unsigned char lds_raw[];
    LAS unsigned char* lds = (LAS unsigned char*)lds_raw;
    cg::grid_group grid = cg::this_grid();
    const int tid = threadIdx.x, lane = tid & 63, wave = __builtin_amdgcn_readfirstlane(tid >> 6);
    const int G = gridDim.x, bx = blockIdx.x;
    if (tid < 2) ((LAS unsigned*)(lds + 133120))[tid] = 0u;
    __syncthreads();

    {
        PHASE_WS
        if (bx == 0) for (int i = tid; i < 4096; i += 512) ((unsigned*)(ws + WS_CTL))[i] = 0u;
        const float* xp = p.in[0]; const float* xs = p.in[1];
        LAS float* scr = (LAS float*)(lds + wave * 16384);
        const int gw = bx * 8 + wave, NGW = G * 8;
        constexpr int I_IN = 16 * 88, I_OUT = 16 * 32, I_MEM = 16 * 8, I_L = I_IN + I_OUT + 2 * I_MEM;
        for (int it = gw; it < 2 * I_L; it += NGW) {
            const int l = it / I_L; int r = it % I_L;
            if (r < I_IN) { transpose_item(p.in[9] + (size_t)l * D * NC, D, NC, WIN + (size_t)l * NC * D, 0, p.in[8] + l * D, scr, r, lane, true); continue; } r -= I_IN;
            if (r < I_OUT) { transpose_item(p.in[21] + (size_t)l * D * D, D, D, WOUT + (size_t)l * D * D, 0, nullptr, scr, r, lane); continue; } r -= I_OUT;
            if (r < I_MEM) { transpose_item(p.in[19] + (size_t)l * D * 256, D, 256, WMEM, l * 512, p.in[18] + l * D, scr, r, lane); continue; } r -= I_MEM;
            transpose_item(p.in[20] + (size_t)l * D * 256, D, 256, WMEM, l * 512 + 256, p.in[18] + l * D, scr, r, lane);
        }
        for (int m0 = gw; m0 < M; m0 += 4 * NGW) {
            f32x4 v[4][4]; float ss[4];
#pragma unroll
            for (int u = 0; u < 4; ++u) {
                const int m = m0 + u * NGW;
                const float* xr = m < NPR ? xp + (size_t)m * D : xs + (size_t)(m - NPR) * D;
#pragma unroll
                for (int j = 0; j < 4; ++j) v[u][j] = (m < M) ? __builtin_nontemporal_load((const f32x4*)xr + lane + 64 * j) : (f32x4){0.f, 0.f, 0.f, 0.f};
            }
#pragma unroll
            for (int u = 0; u < 4; ++u) {
                float a = 0.f;
#pragma unroll
                for (int j = 0; j < 4; ++j) a += (v[u][j].x * v[u][j].x + v[u][j].y * v[u][j].y) + (v[u][j].z * v[u][j].z + v[u][j].w * v[u][j].w);
                ss[u] = wave_sum(a);
            }
#pragma unroll
            for (int u = 0; u < 4; ++u) {
                const int m = m0 + u * NGW;
                if (m < M) {
                    v2u* o8 = (v2u*)(XB + (size_t)m * D) + lane;
#pragma unroll
                    for (int j = 0; j < 4; ++j) { v2u w; w.x = cvtpk(v[u][j].x, v[u][j].y); w.y = cvtpk(v[u][j].z, v[u][j].w); o8[64 * j] = w; }
                    if (lane < 16) SSPA[(size_t)m * 16 + lane] = (lane == 0) ? ss[u] : 0.f;
                }
            }
        }
        for (int m = gw; m < 1024; m += NGW) {
            const float ss = row_to_bf16(p.in[2] + (size_t)m * D, MNB + (size_t)m * D, lane);
            if (lane == 0) RSM[m] = rsqrtf(ss * (1.f / 1024.f) + EPS);
        }
        for (int i8 = bx * 512 + tid; i8 < 2 * 32 * 65536 / 8; i8 += G * 512) {
            const size_t i = (size_t)i8 * 8; const int l = (int)(i >> 21), b = (int)((i >> 16) & 31), mem = (int)((i >> 8) & 255), h = (int)((i >> 6) & 3), d = (int)(i & 63);
            const f32x4 a = *(const f32x4*)(p.in[6] + i), c = *(const f32x4*)(p.in[6] + i + 4);
            v4u o; o.x = cvtpk(a.x, a.y); o.y = cvtpk(a.z, a.w); o.z = cvtpk(c.x, c.y); o.w = cvtpk(c.z, c.w);
            const int mt = (mem >> 5) * 2 + ((mem >> 2) & 1), r = ((mem >> 3) & 3) * 4 + (mem & 3), kk = d >> 5, q = (d >> 3) & 3;
            *(v4u*)(W_KB + ((size_t)((l * NSEQ + 4 + b) * 4 + h) * 32 + mt * 2 + kk) * 512 + (q * 16 + r) * 8) = o;
        }
        for (int it = gw; it < 8192; it += NGW) {
            const int mg = it & 31, h = (it >> 5) & 3, b = (it >> 7) & 31, l = it >> 12;
            float f[8];
#pragma unroll
            for (int i = 0; i < 8; ++i) f[i] = p.in[7][(((size_t)(l * 32 + b) * 256 + mg * 8 + i) * 4 + h) * 64 + lane];
            const int mp = mg >> 2, q = mg & 3, dt = lane >> 4, r = lane & 15;
            *(v4u*)(W_VT + ((size_t)((l * NSEQ + 4 + b) * 4 + h) * 32 + mp * 4 + dt) * 512 + (q * 16 + r) * 8) = pack8(f);
        }
        for (int i = bx * 512 + tid; i < 32768; i += G * 512) {
            const int c = i & 63, e = (i >> 6) & 63, lg = i >> 12;
            W_PWT[i] = (bf16)(cvtpk(p.in[15][((size_t)lg * 64 + c) * 64 + e], 0.f) & 0xffffu);
        }
    }
    grid.sync();
    const XcdBarrier bar = xcd_barrier_post((unsigned*)(p.ws + WS_CTL), (volatile LAS unsigned*)(lds + 133120));

    {
        PHASE_WS
        pg8::Gemm g{MNB, WMEM, 1024, 1024, D}; pg8::StaticOrder S; S.init(1024, 1024, G, G - 1 - bx);
        EpiKV E{RSM, p.out, W_KB, W_VT};
        pg8::gemm_phase<EpiKV, pg8::StaticOrder, false, true>(lds, g, S, E);
    }

    for (int l = 0; l < 2; ++l) {
        {
            PHASE_WS
            pg8::Gemm g{XB, WIN + (size_t)l * NC * D, M, NC, D}; pg8::StaticOrder S; S.init(M, NC, G, bx);
            EpiU E{UB, l == 0 ? SSPA : SSPB};
            pg8::gemm_phase<EpiU, pg8::StaticOrder, true, true>(lds, g, S, E);
        }
        xcd_barrier(bar);
        {
            PHASE_WS
            Lay L;
            L.U = UB; L.Y = YB; L.KB = W_KB + (size_t)l * NSEQ * 65536; L.VT = W_VT + (size_t)l * NSEQ * 65536; L.PWT = W_PWT + (size_t)l * 16384;
            L.caw = p.in[10] + l * 768; L.cbw = p.in[11] + l * 31 * 256; L.cbb = p.in[12] + l * 256; L.lng = p.in[13] + l * 256; L.lnb = p.in[14] + l * 256;
            L.pbias = p.in[16] + l * 256; L.pscale = p.in[17] + l * 256;
            L.sta = p.in[3] + (size_t)l * 32 * 2 * 256; L.stb = p.in[4] + (size_t)l * 32 * 30 * 256; L.stp = p.in[5] + (size_t)l * 32 * 15 * 256;
            L.out = p.out; L.l = l;
            const int nk = (5 * NTILE - bx + G - 1) / G;
            for (int kk = 0; kk < nk; ++kk) {
                int k2 = kk + (bx >> 3) % nk; if (k2 >= nk) k2 -= nk;
                const int idx = bx + k2 * G;
                const int grp = idx / NTILE; const Tile T = mk_tile(idx % NTILE); const int hp = grp - 2;
                if (grp == 0) mix_b(L, T, tid, lds);
                else if (grp == 1) mix_c(L, T, tid, lds);
                else if (grp < 4) mix_x(L, T, hp, tid, lds);
                else mix_a(L, T, tid);
            }
        }
        xcd_barrier(bar);
        {
            PHASE_WS
            pg8::Gemm g{YB, WOUT + (size_t)l * D * D, M, D, D}; pg8::StaticOrder S; S.init(M, D, G, bx);
            EpiX E{XB, l == 0 ? SSPB : SSPA, XB};
            pg8::gemm_phase<EpiX, pg8::StaticOrder, true, true>(lds, g, S, E);
        }
        xcd_barrier(bar);
    }
    {
        PHASE_WS
        const int gw = bx * 8 + wave, NGW = G * 8;
        const float* gf = p.in[22];
        f32x4 gv[4];
#pragma unroll
        for (int j = 0; j < 4; ++j) gv[j] = ((const f32x4*)gf)[lane + 64 * j];
        for (int m = gw; m < M; m += NGW) {
            const f32x4* sp = (const f32x4*)(SSPA + (size_t)m * 16);
            const f32x4 s0 = sp[0], s1 = sp[1], s2 = sp[2], s3 = sp[3];
            const float ss = ((s0.x + s0.y) + (s0.z + s0.w)) + ((s1.x + s1.y) + (s1.z + s1.w)) + ((s2.x + s2.y) + (s2.z + s2.w)) + ((s3.x + s3.y) + (s3.z + s3.w));
            const float rstd = rsqrtf(ss * (1.f / 1024.f) + EPS);
            const v2u* xr = (const v2u*)(XB + (size_t)m * D) + lane;
            f32x4* yr = (f32x4*)(p.out + (size_t)m * D) + lane;
            v2u xv[4];
#pragma unroll
            for (int j = 0; j < 4; ++j) xv[j] = __builtin_nontemporal_load(xr + 64 * j);
#pragma unroll
            for (int j = 0; j < 4; ++j) { const f32x4 v = (f32x4){bflo(xv[j].x), bfhi(xv[j].x), bflo(xv[j].y), bfhi(xv[j].y)}; __builtin_nontemporal_store(v * rstd * gv[j], yr + 64 * j); }
        }
    }
}

extern "C" void kernel_launch(void* const* d_in, const int* in_sizes, int n_in, void* d_out, int out_size, void* d_ws, size_t ws_size, hipStream_t stream) {
    static int grid_blocks = 0;
    if (grid_blocks == 0) {
        if (n_in != 23 || (size_t)out_size != O_END || ws_size < WS_END) { fprintf(stderr, "kernel_launch: unexpected shapes (n_in %d out %d ws %zu)\n", n_in, out_size, ws_size); grid_blocks = -1; return; }
        int dev = 0, cus = 0, per_cu = 0;
        hipGetDevice(&dev);
        hipDeviceGetAttribute(&cus, hipDeviceAttributeMultiprocessorCount, dev);
        if (hipFuncSetAttribute((const void*)hymba_fwd, hipFuncAttributeMaxDynamicSharedMemorySize, LDS_BYTES) != hipSuccess) { fprintf(stderr, "kernel_launch: hipFuncSetAttribute failed\n"); grid_blocks = -1; return; }
        if (hipOccupancyMaxActiveBlocksPerMultiprocessor(&per_cu, (const void*)hymba_fwd, 512, LDS_BYTES) != hipSuccess || per_cu < 1) { fprintf(stderr, "kernel_launch: occupancy query says %d\n", per_cu); per_cu = 1; }
        (void)hipGetLastError();
        grid_blocks = cus * 1;
    }
    if (grid_blocks < 0) return;
    Params p{};
    for (int i = 0; i < 23; ++i) p.in[i] = (const float*)d_in[i];
    p.out = (float*)d_out; p.ws = (unsigned char*)d_ws;
    void* args[] = {&p};
    hipError_t e = hipLaunchCooperativeKernel((const void*)hymba_fwd, dim3(grid_blocks), dim3(512), args, LDS_BYTES, stream);
    if (e != hipSuccess) fprintf(stderr, "cooperative launch failed: %s (grid %d)\n", hipGetErrorString(e), grid_blocks);
}
```

```cpp
#include <hip/hip_runtime.h>
#include <hip/hip_cooperative_groups.h>
#include <cstdio>
#include <cstdint>
namespace cg = cooperative_groups;
namespace pg8 {
#define PG8_LAS __attribute__((address_space(3)))
typedef unsigned short bf16_t;
typedef short bf16x8 __attribute__((ext_vector_type(8)));
typedef float f32x4 __attribute__((ext_vector_type(4)));
typedef unsigned u32x4 __attribute__((ext_vector_type(4)));
constexpr int BM = 256, BK = 64, HALF = 128, HTB = HALF * BK * 2  , STAGE_BYTES = 8 * HTB, NXCD = 8, WGM = 8;

__host__ __device__ __forceinline__ int lds_byte(int r, int c) { const int st = (r >> 4) * 2 + (c >> 5), rr = r & 15, cc = c & 31, ob = rr * 64 + cc * 2; return st * 1024 + (ob ^ (((ob >> 9) & 1) << 5)); }
__host__ __device__ __forceinline__ void stage_rc(int b, int& R, int& C) { const int st = b / 1024, sb = b % 1024, swz = sb ^ (((sb >> 9) & 1) << 5); R = (st >> 1) * 16 + swz / 64; C = (st & 1) * 32 + (swz % 64) / 2; }
__host__ __device__ __forceinline__ int perm32(int rho) { const int n = rho >> 4, i = rho & 15; return 8 * (i >> 2) + 4 * n + (i & 3); }

struct Unit { int pm, pn; };
struct Gemm { const bf16_t* A; const bf16_t* Bt; int M, N, K; };

struct StaticOrder {
    int nM, nN, nwg, G, c;
    __host__ __device__ void init(int M, int N, int G_, int c_) { nM = M / BM; nN = N / BM; nwg = nM * nN; G = G_; c = c_; }
    __host__ __device__ bool next(int i, Unit& u) const {
        const long L = (long)i * G + c; if (L >= nwg) return false;
        int wgid = (int)L; { const int q = nwg / NXCD, r = nwg % NXCD, xcd = wgid % NXCD, off = wgid / NXCD; wgid = (xcd < r ? xcd * (q + 1) : r * (q + 1) + (xcd - r) * q) + off; }
        const int nig = WGM * nN, gid = wgid / nig, fm = gid * WGM, gsz = (nM - fm) < WGM ? (nM - fm) : WGM;
        u.pm = fm + ((wgid % nig) % gsz); u.pn = (wgid % nig) / gsz; return true;
    }
    __device__ __forceinline__ void a_ready(const Unit&) const {}
    __device__ __forceinline__ void done(const Unit&) const {}
};
__device__ __forceinline__ unsigned cvt_pk_bf16(float lo, float hi) { unsigned r; asm volatile("v_cvt_pk_bf16_f32 %0, %1, %2" : "=v"(r) : "v"(lo), "v"(hi)); return r; }
template <class Epi, class Sched, bool ALIGN_EPI = false, bool SP2 = false>
__device__ __forceinline__ void gemm_phase(PG8_LAS unsigned char* lds, const Gemm g, const Sched& S, const Epi& E) {
    const int tid = threadIdx.x, wid = __builtin_amdgcn_readfirstlane(tid >> 6), lane = tid & 63, wr = wid >> 2, wc = wid & 3, fr = lane & 15, fq = lane >> 4;
    const int K = g.K, nt = K / BK;
    unsigned voffA[2], voffB[2];
#pragma unroll
    for (int i = 0; i < 2; ++i) { int R, C; stage_rc(tid * 16 + i * 8192, R, C); const int Rb = Epi::PERM ? ((R & ~31) + perm32(R & 31)) : R;
        voffA[i] = (unsigned)(R * K + C) * 2u; voffB[i] = (unsigned)(Rb * K + C) * 2u; }
    const size_t kstep = (size_t)(BK * 2);
    const size_t hstep = (size_t)HALF * K * 2;
    const size_t tstep = 2 * hstep;
    const unsigned ldsw = (unsigned)wid * 1024u;
    const int aoff = lds_byte(wr * 64 + fr, fq * 8), boff = lds_byte(wc * 32 + fr, fq * 8);
#define PG8_SA(b, h) (((b) * 2 + (h)) * HTB)
#define PG8_SB(b, h) ((4 + (b) * 2 + (h)) * HTB)
#define PG8_STAGE(bufoff, gbase, voff) do { _Pragma("unroll") for (int _i = 0; _i < 2; ++_i) \
        __builtin_amdgcn_global_load_lds((const unsigned*)((const char*)(gbase) + (voff)[_i]), (PG8_LAS unsigned*)(lds + (bufoff) + ldsw + _i * 8192), 16, 0, 0); } while (0)
#define PG8_LDA(dst, b, h) do { _Pragma("unroll") for (int m = 0; m < 4; ++m) _Pragma("unroll") for (int k = 0; k < 2; ++k) dst[m][k] = *(const PG8_LAS bf16x8*)(lds + PG8_SA(b, h) + aoff + m * 2048 + k * 1024); } while (0)
#define PG8_LDB(dst, b, h) do { _Pragma("unroll") for (int n = 0; n < 2; ++n) _Pragma("unroll") for (int k = 0; k < 2; ++k) dst[n][k] = *(const PG8_LAS bf16x8*)(lds + PG8_SB(b, h) + boff + n * 2048 + k * 1024); } while (0)
#define PG8_MMA(ai, bj, At, Bt) do { __builtin_amdgcn_s_setprio(1); _Pragma("unroll") for (int m = 0; m < 4; ++m) _Pragma("unroll") for (int n = 0; n < 2; ++n) _Pragma("unroll") for (int k = 0; k < 2; ++k) \
        acc[ai][bj][m][n] = __builtin_amdgcn_mfma_f32_16x16x32_bf16(Bt[n][k], At[m][k], acc[ai][bj][m][n], 0, 0, 0); __builtin_amdgcn_s_setprio(0); } while (0)
#define PG8_WAIT_V(n) asm volatile("s_waitcnt vmcnt(" #n ")" ::: "memory")
#define PG8_WAIT_L(n) asm volatile("s_waitcnt lgkmcnt(" #n ")" ::: "memory")
#define PG8_BAR __builtin_amdgcn_s_barrier()
#define PG8_SCHED __builtin_amdgcn_sched_barrier(0)
    Unit cur, nxt; int ui = 0;
    if (!S.next(0, cur)) return;
    f32x4 acc[2][2][4][2];
#pragma unroll
    for (int a = 0; a < 2; ++a)
#pragma unroll
        for (int b = 0; b < 2; ++b)
#pragma unroll
            for (int m = 0; m < 4; ++m)
#pragma unroll
                for (int n = 0; n < 2; ++n) acc[a][b][m][n] = (f32x4){0.f, 0.f, 0.f, 0.f};
    bf16x8 At[4][2], B0[2][2], B1[2][2];
    const char* cA = (const char*)g.A + (size_t)cur.pm * tstep; const char* cB = (const char*)g.Bt + (size_t)cur.pn * tstep;
    S.a_ready(cur);
    if constexpr (SP2) {
        PG8_STAGE(PG8_SB(0, 0), cB, voffB); PG8_STAGE(PG8_SB(0, 1), cB + hstep, voffB); PG8_STAGE(PG8_SA(0, 0), cA, voffA); PG8_STAGE(PG8_SA(0, 1), cA + hstep, voffA);
        if (wr == 1) PG8_BAR;
        PG8_WAIT_V(2); PG8_BAR;
        PG8_STAGE(PG8_SB(1, 0), cB + kstep, voffB); PG8_STAGE(PG8_SA(1, 0), cA + kstep, voffA); PG8_STAGE(PG8_SB(1, 1), cB + hstep + kstep, voffB);
        PG8_WAIT_V(6); PG8_BAR;
    } else {
        PG8_STAGE(PG8_SB(0, 0), cB, voffB); PG8_STAGE(PG8_SA(0, 0), cA, voffA); PG8_STAGE(PG8_SB(0, 1), cB + hstep, voffB); PG8_STAGE(PG8_SA(0, 1), cA + hstep, voffA);
        if (wr == 1) PG8_BAR;
        PG8_WAIT_V(4); PG8_BAR;
        PG8_STAGE(PG8_SB(1, 0), cB + kstep, voffB); PG8_STAGE(PG8_SA(1, 0), cA + kstep, voffA); PG8_STAGE(PG8_SB(1, 1), cB + hstep + kstep, voffB);
        PG8_WAIT_V(6); PG8_BAR;
    }
    for (;;) {
        const bool has_next = S.next(ui + 1, nxt);
        const char* nA = has_next ? (const char*)g.A + (size_t)nxt.pm * tstep : cA; const char* nB = has_next ? (const char*)g.Bt + (size_t)nxt.pn * tstep : cB;
        for (int t = 0; t < nt; t += 2) {
            const bool last = (t == nt - 2);
            const char* a1 = cA + (size_t)(t + 1) * kstep;
            const char* a2 = last ? nA : cA + (size_t)(t + 2) * kstep; const char* b2 = last ? nB : cB + (size_t)(t + 2) * kstep;
            const char* a3 = a2 + kstep; const char* b3 = b2 + kstep;
            if (last && has_next) S.a_ready(nxt);
            if constexpr (SP2) {
            PG8_LDB(B0, 0, 0); PG8_LDB(B1, 0, 1); PG8_SCHED; PG8_LDA(At, 0, 0); PG8_STAGE(PG8_SA(1, 1), a1 + hstep, voffA);
            PG8_WAIT_V(8); PG8_WAIT_L(0); PG8_BAR; PG8_MMA(0, 0, At, B0); PG8_MMA(0, 1, At, B1); PG8_BAR; PG8_SCHED;
            PG8_LDA(At, 0, 1); PG8_STAGE(PG8_SB(0, 0), b2, voffB); PG8_STAGE(PG8_SB(0, 1), b2 + hstep, voffB); PG8_STAGE(PG8_SA(0, 0), a2, voffA);
            PG8_WAIT_V(8); PG8_WAIT_L(0); PG8_BAR; PG8_MMA(1, 0, At, B0); PG8_MMA(1, 1, At, B1); PG8_BAR; PG8_SCHED;
            PG8_LDB(B0, 1, 0); PG8_LDB(B1, 1, 1); PG8_SCHED; PG8_LDA(At, 1, 0); PG8_STAGE(PG8_SA(0, 1), a2 + hstep, voffA);
            PG8_WAIT_V(8); PG8_WAIT_L(0); PG8_BAR; PG8_MMA(0, 0, At, B0); PG8_MMA(0, 1, At, B1); PG8_BAR; PG8_SCHED;
            PG8_LDA(At, 1, 1); PG8_STAGE(PG8_SB(1, 0), b3, voffB); PG8_STAGE(PG8_SB(1, 1), b3 + hstep, voffB); PG8_STAGE(PG8_SA(1, 0), a3, voffA);
            PG8_WAIT_V(8); PG8_WAIT_L(0); PG8_BAR; PG8_MMA(1, 0, At, B0); PG8_MMA(1, 1, At, B1); PG8_BAR; PG8_SCHED;
            } else {
            PG8_LDB(B0, 0, 0); PG8_SCHED; PG8_LDA(At, 0, 0); PG8_STAGE(PG8_SA(1, 1), a1 + hstep, voffA);
            PG8_WAIT_L(8); PG8_BAR; PG8_WAIT_L(0); PG8_MMA(0, 0, At, B0); PG8_BAR; PG8_SCHED;
            PG8_LDB(B1, 0, 1); PG8_STAGE(PG8_SB(0, 0), b2, voffB);
            PG8_BAR; PG8_WAIT_L(0); PG8_MMA(0, 1, At, B1); PG8_BAR;
            PG8_LDA(At, 0, 1); PG8_STAGE(PG8_SA(0, 0), a2, voffA);
            PG8_BAR; PG8_WAIT_L(0); PG8_MMA(1, 0, At, B0); PG8_BAR; PG8_SCHED;
            PG8_STAGE(PG8_SB(0, 1), b2 + hstep, voffB);
            PG8_WAIT_V(6); PG8_BAR; PG8_MMA(1, 1, At, B1); PG8_BAR;
            PG8_LDB(B0, 1, 0); PG8_SCHED; PG8_LDA(At, 1, 0); PG8_STAGE(PG8_SA(0, 1), a2 + hstep, voffA);
            PG8_WAIT_L(8); PG8_BAR; PG8_WAIT_L(0); PG8_MMA(0, 0, At, B0); PG8_BAR; PG8_SCHED;
            PG8_LDB(B1, 1, 1); PG8_STAGE(PG8_SB(1, 0), b3, voffB);
            PG8_BAR; PG8_WAIT_L(0); PG8_MMA(0, 1, At, B1); PG8_BAR;
            PG8_LDA(At, 1, 1); PG8_STAGE(PG8_SA(1, 0), a3, voffA);
            PG8_BAR; PG8_WAIT_L(0); PG8_MMA(1, 0, At, B0); PG8_BAR; PG8_SCHED;
            PG8_STAGE(PG8_SB(1, 1), b3 + hstep, voffB);
            PG8_WAIT_V(6); PG8_BAR; PG8_MMA(1, 1, At, B1); PG8_BAR;
            }
        }
        if constexpr (ALIGN_EPI) { if (wr == 0) PG8_BAR; }
        if constexpr (!Epi::AFTER_DRAIN) { E(acc, cur, wr, wc, fr, fq); S.done(cur); }
        if (!has_next) break;
#pragma unroll
        for (int a = 0; a < 2; ++a)
#pragma unroll
            for (int b = 0; b < 2; ++b)
#pragma unroll
                for (int m = 0; m < 4; ++m)
#pragma unroll
                    for (int n = 0; n < 2; ++n) acc[a][b][m][n] = (f32x4){0.f, 0.f, 0.f, 0.f};
        cur = nxt; cA = nA; cB = nB; ++ui;
        if constexpr (ALIGN_EPI) { if (wr == 1) PG8_BAR; }
    }
    PG8_WAIT_V(0);
    if constexpr (!ALIGN_EPI) { if (wr == 0) PG8_BAR; }
    PG8_BAR;
    if constexpr (Epi::AFTER_DRAIN) { E.fused(acc, cur, wr, wc, fr, fq, lds, wid, lane); S.done(cur); }
#undef PG8_SA
#undef PG8_SB
#undef PG8_STAGE
#undef PG8_LDA
#undef PG8_LDB
#undef PG8_MMA
#undef PG8_WAIT_V
#undef PG8_WAIT_L
#undef PG8_BAR
#undef PG8_SCHED
}
}

#define LAS __attribute__((address_space(3)))
typedef unsigned short bf16;
typedef unsigned v4u __attribute__((ext_vector_type(4)));
typedef unsigned v2u __attribute__((ext_vector_type(2)));
typedef float f32x4 __attribute__((ext_vector_type(4)));
typedef short bf16x8 __attribute__((ext_vector_type(8)));

constexpr int D = 1024, NPR = 32768, NSR = 2048, M = NPR + NSR, NC = 2816, NSEQ = 36, NTILE = M / 64;
constexpr float EPS = 1e-6f;
constexpr size_t O_Y = 0, O_NAP = 35651584, O_NBP = O_NAP + 4096, O_NPP = O_NBP + 61440, O_MKP = O_NPP + 30720, O_MVP = O_MKP + 524288,
                 O_NAS = O_MVP + 524288, O_NBS = O_NAS + 32768, O_NPS = O_NBS + 491520, O_END = O_NPS + 245760;
constexpr size_t MiB = 1u << 20;
constexpr size_t WS_WIN = 0, WS_WOUT = 12 * MiB, WS_WMEM = 16 * MiB, WS_PWT = 18 * MiB, WS_RSM = 18 * MiB + 65536, WS_SSPA = 19 * MiB, WS_SSPB = 22 * MiB,
                 WS_CTL = 24 * MiB + 512 * 1024, WS_MNB = 25 * MiB, WS_KB = 28 * MiB, WS_VT = 38 * MiB, WS_XB = 48 * MiB, WS_Y = 116 * MiB, WS_U = 184 * MiB, WS_END = 372 * MiB;
constexpr int LDS_BYTES = 135168;

struct Params { const float* in[23]; float* out; unsigned char* ws; };

__device__ __forceinline__ unsigned cvtpk(float lo, float hi) { unsigned r; asm("v_cvt_pk_bf16_f32 %0, %1, %2" : "=v"(r) : "v"(lo), "v"(hi)); return r; }
__device__ __forceinline__ float bflo(unsigned u) { return __uint_as_float(u << 16); }
__device__ __forceinline__ float bfhi(unsigned u) { return __uint_as_float(u & 0xffff0000u); }
__device__ __forceinline__ float bf1(bf16 b) { return __uint_as_float(((unsigned)b) << 16); }
__device__ __forceinline__ float sigm(float x) { return __builtin_amdgcn_rcpf(1.f + __builtin_amdgcn_exp2f(-1.44269504f * x)); }
__device__ __forceinline__ float silu(float x) { return x * sigm(x); }
__device__ __forceinline__ void unpack8(v4u u, float (&f)[8]) { f[0] = bflo(u.x); f[1] = bfhi(u.x); f[2] = bflo(u.y); f[3] = bfhi(u.y); f[4] = bflo(u.z); f[5] = bfhi(u.z); f[6] = bflo(u.w); f[7] = bfhi(u.w); }
__device__ __forceinline__ v4u pack8(const float (&f)[8]) { v4u o; o.x = cvtpk(f[0], f[1]); o.y = cvtpk(f[2], f[3]); o.z = cvtpk(f[4], f[5]); o.w = cvtpk(f[6], f[7]); return o; }
__device__ __forceinline__ float wave_sum(float v) {
#pragma unroll
    for (int o = 1; o < 64; o <<= 1) v += __shfl_xor(v, o);
    return v;
}
#define LDS_WAIT() asm volatile("s_waitcnt lgkmcnt(0)" ::: "memory")

struct EpiU {
    static constexpr bool PERM = true, AFTER_DRAIN = false;
    bf16* U; const float* ssp;
    __device__ __forceinline__ void operator()(const f32x4 (&acc)[2][2][4][2], const pg8::Unit& u, int wr, int wc, int fr, int fq) const {
        const int row0 = u.pm * 256 + wr * 64 + fr, pn = u.pn, lc = wc * 32 + 8 * fq;
        float rs[2][4];
        {
            f32x4 sq[2][4];
#pragma unroll
            for (int ai = 0; ai < 2; ++ai)
#pragma unroll
                for (int m = 0; m < 4; ++m) sq[ai][m] = *(const f32x4*)(ssp + (size_t)(row0 + ai * 128 + m * 16) * 16 + fq * 4);
#pragma unroll
            for (int ai = 0; ai < 2; ++ai)
#pragma unroll
                for (int m = 0; m < 4; ++m) {
                    float t = (sq[ai][m].x + sq[ai][m].y) + (sq[ai][m].z + sq[ai][m].w);
                    t += __shfl_xor(t, 16); t += __shfl_xor(t, 32);
                    rs[ai][m] = rsqrtf(t * (1.0f / 1024.0f) + EPS);
                }
        }
#pragma unroll
        for (int ai = 0; ai < 2; ++ai)
#pragma unroll
            for (int m = 0; m < 4; ++m) {
                const int row = row0 + ai * 128 + m * 16;
                const float rstd = rs[ai][m];
                bf16* rowp = U + (size_t)row * 2048;
                if (pn < 6) {
                    const f32x4 a0 = acc[ai][0][m][0] * rstd, a1 = acc[ai][0][m][1] * rstd, g0 = acc[ai][1][m][0] * rstd, g1 = acc[ai][1][m][1] * rstd;
                    float o[8];
                    if ((pn >> 1) == 0) {
#pragma unroll
                        for (int j = 0; j < 4; ++j) { o[j] = a0[j] * silu(g0[j]); o[4 + j] = a1[j] * silu(g1[j]); }
                    } else if ((pn >> 1) == 1) {
#pragma unroll
                        for (int j = 0; j < 4; ++j) { o[j] = a0[j] * g0[j]; o[4 + j] = a1[j] * g1[j]; }
                    } else {
#pragma unroll
                        for (int j = 0; j < 4; ++j) { o[j] = a0[j] * sigm(g0[j]); o[4 + j] = a1[j] * sigm(g1[j]); }
                    }
                    *(v4u*)(rowp + (pn >> 1) * 256 + (pn & 1) * 128 + lc) = pack8(o);
                } else {
                    const float sc = (pn == 9) ? rstd * (0.125f * 1.44269504f) : rstd;
                    const bool act = (pn & 1) == 0;
#pragma unroll
                    for (int bj = 0; bj < 2; ++bj) {
                        const f32x4 v0 = acc[ai][bj][m][0] * sc, v1 = acc[ai][bj][m][1] * sc;
                        float o[8];
#pragma unroll
                        for (int j = 0; j < 4; ++j) { o[j] = act ? silu(v0[j]) : v0[j]; o[4 + j] = act ? silu(v1[j]) : v1[j]; }
                        *(v4u*)(rowp + 768 + (pn - 6) * 256 + bj * 128 + lc) = pack8(o);
                    }
                }
            }
    }
};
struct EpiX {
    static constexpr bool PERM = true, AFTER_DRAIN = false;
    bf16* XB; float* ssp; bf16* XO;
    __device__ __forceinline__ void operator()(const f32x4 (&acc)[2][2][4][2], const pg8::Unit& u, int wr, int wc, int fr, int fq) const {
        const int row0 = u.pm * 256 + wr * 64 + fr, col0 = u.pn * 256 + wc * 32 + 8 * fq;
#pragma unroll
        for (int ai = 0; ai < 2; ++ai) {
            v4u xv[4][2];
#pragma unroll
            for (int m = 0; m < 4; ++m)
#pragma unroll
                for (int bj = 0; bj < 2; ++bj) xv[m][bj] = *(const v4u*)(XB + (size_t)(row0 + ai * 128 + m * 16) * D + col0 + bj * 128);
#pragma unroll
            for (int m = 0; m < 4; ++m) {
                const int row = row0 + ai * 128 + m * 16;
                float ss = 0.f;
#pragma unroll
                for (int bj = 0; bj < 2; ++bj) {
                    float xo[8]; unpack8(xv[m][bj], xo);
                    const f32x4 a0 = acc[ai][bj][m][0], a1 = acc[ai][bj][m][1];
#pragma unroll
                    for (int j = 0; j < 4; ++j) { xo[j] += a0[j]; xo[4 + j] += a1[j]; }
#pragma unroll
                    for (int j = 0; j < 8; ++j) ss += xo[j] * xo[j];
                    *(v4u*)(XO + (size_t)row * D + col0 + bj * 128) = pack8(xo);
                }
                ss += __shfl_xor(ss, 16); ss += __shfl_xor(ss, 32);
                if (fq == 0) ssp[(size_t)row * 16 + u.pn * 4 + wc] = ss;
            }
        }
    }
};
struct EpiKV {
    static constexpr bool PERM = false, AFTER_DRAIN = true;
    const float* rsm; float* out; bf16* KB; bf16* VT;
    __device__ __forceinline__ void operator()(const f32x4 (&)[2][2][4][2], const pg8::Unit&, int, int, int, int) const {}
    __device__ __forceinline__ void fused(f32x4 (&acc)[2][2][4][2], const pg8::Unit& u, int wr, int wc, int fr, int fq, PG8_LAS unsigned char* lds, int wid, int lane) const {
        const int l = u.pn >> 1, isv = u.pn & 1, b = u.pm;
        const int mem0 = wr * 64 + fr, c0 = wc * 32 + 4 * fq;
        float* ob = out + O_MKP + (size_t)isv * (O_MVP - O_MKP) + (size_t)(l * 4 + b) * 65536;
        PG8_LAS bf16* img = (PG8_LAS bf16*)lds;
#pragma unroll
        for (int ai = 0; ai < 2; ++ai)
#pragma unroll
            for (int m = 0; m < 4; ++m) {
                const int mem = mem0 + ai * 128 + m * 16;
                const float rs = rsm[b * 256 + mem];
#pragma unroll
                for (int bj = 0; bj < 2; ++bj)
#pragma unroll
                    for (int n = 0; n < 2; ++n) {
                        const int c = c0 + bj * 128 + n * 16;
                        const f32x4 v = acc[ai][bj][m][n] * rs;
                        *(f32x4*)(ob + (size_t)mem * 256 + c) = v;
                        const int h = c >> 6, d = c & 63;
                        const unsigned w0 = cvtpk(v[0], v[1]), w1 = cvtpk(v[2], v[3]);
                        if (!isv) {
                            const int mt = (mem >> 5) * 2 + ((mem >> 2) & 1), r = ((mem >> 3) & 3) * 4 + (mem & 3), kk = d >> 5, q = (d >> 3) & 3, e = d & 7;
                            *(PG8_LAS v2u*)(img + ((h * 32 + mt * 2 + kk) * 512 + (q * 16 + r) * 8 + e)) = (v2u){w0, w1};
                        } else {
                            const int mp = mem >> 5, q = (mem >> 3) & 3, e = mem & 7, dt = d >> 4, r = d & 15;
                            PG8_LAS bf16* vp = img + ((h * 32 + mp * 4 + dt) * 512 + (q * 16 + r) * 8 + e);
                            vp[0] = (bf16)(w0 & 0xffffu); vp[8] = (bf16)(w0 >> 16); vp[16] = (bf16)(w1 & 0xffffu); vp[24] = (bf16)(w1 >> 16);
                        }
                    }
            }
        asm volatile("s_waitcnt lgkmcnt(0)" ::: "memory"); __builtin_amdgcn_s_barrier(); asm volatile("" ::: "memory");
        bf16* dst = KB + (ptrdiff_t)isv * (VT - KB) + (size_t)(l * NSEQ + b) * 65536;
        const int tid = wid * 64 + lane;
#pragma unroll
        for (int i = 0; i < 16; ++i) { const int ch = tid + 512 * i; *(v4u*)(dst + (size_t)ch * 8) = *(const PG8_LAS v4u*)(img + ch * 8); }
        asm volatile("s_waitcnt lgkmcnt(0)" ::: "memory"); __builtin_amdgcn_s_barrier(); asm volatile("" ::: "memory");
    }
};

__device__ __forceinline__ void transpose_item(const float* W, int K, int N, bf16* WT, int row_off, const float* gs, LAS float* scr, int item, int lane, bool remap = false) {
    const int nblk = N / 32, kb = item / nblk, nb = item % nblk, k0 = 64 * kb, n0 = 32 * nb;
    int d0 = n0;
    if (remap) { const int sp = n0 >> 8, ch = n0 & 255; if (sp < 6) { const int pair = (sp == 0 || sp == 3) ? 0 : ((sp == 1 || sp == 2) ? 1 : 2), bj = (sp == 3 || sp == 2 || sp == 5) ? 1 : 0; d0 = (pair * 2 + (ch >> 7)) * 256 + bj * 128 + (ch & 127); } }
    f32x4 tv[8];
#pragma unroll
    for (int i = 0; i < 8; ++i) { const int kk = 8 * i + (lane >> 3); tv[i] = *(const f32x4*)(W + (size_t)(k0 + kk) * N + n0 + (lane & 7) * 4); }
#pragma unroll
    for (int i = 0; i < 8; ++i) { const int kk = 8 * i + (lane >> 3); f32x4 v = tv[i]; if (gs) v = v * gs[k0 + kk];
        LAS float* d = scr + kk * 33 + (lane & 7) * 4; d[0] = v.x; d[1] = v.y; d[2] = v.z; d[3] = v.w; }
    LDS_WAIT();
    const int c = lane & 7;
#pragma unroll
    for (int j = 0; j < 4; ++j) { const int n = (lane >> 3) + 8 * j; const LAS float* s = scr + (8 * c) * 33 + n;
        v4u o; o.x = cvtpk(s[0 * 33], s[1 * 33]); o.y = cvtpk(s[2 * 33], s[3 * 33]); o.z = cvtpk(s[4 * 33], s[5 * 33]); o.w = cvtpk(s[6 * 33], s[7 * 33]);
        *(v4u*)(WT + (size_t)(row_off + d0 + n) * K + k0 + 8 * c) = o; }
    LDS_WAIT();
}
__device__ __forceinline__ float row_to_bf16(const float* xrow, bf16* orow, int lane) {
    const f32x4* xr = (const f32x4*)xrow + lane;
    f32x4 v[4]; float s = 0.f;
#pragma unroll
    for (int j = 0; j < 4; ++j) { v[j] = xr[64 * j]; s += (v[j].x * v[j].x + v[j].y * v[j].y) + (v[j].z * v[j].z + v[j].w * v[j].w); }
    s = wave_sum(s);
    v2u* o8 = (v2u*)orow + lane;
#pragma unroll
    for (int j = 0; j < 4; ++j) { v2u w; w.x = cvtpk(v[j].x, v[j].y); w.y = cvtpk(v[j].z, v[j].w); o8[64 * j] = w; }
    return s;
}

constexpr int UC = 2048, C_ABG = 0, C_V = 256, C_GLU = 512, C_SBG = 768, C_CU = 1024, C_SCG = 1280, C_Q = 1536, C_SXG = 1792;
struct Lay {
    const bf16* U; bf16* Y; const bf16* KB; const bf16* VT; const bf16* PWT;
    const float *caw, *cbw, *cbb, *lng, *lnb, *pbias, *pscale, *sta, *stb, *stp;
    float* out; int l;
};
struct Tile { int row0, seq, t0, first, last, samp, b; };
__device__ __forceinline__ Tile mk_tile(int tt) {
    Tile T; T.row0 = tt * 64;
    if (tt < 512) { T.seq = tt >> 7; T.t0 = (tt & 127) * 64; T.first = (tt & 127) == 0; T.last = (tt & 127) == 127; T.samp = 0; T.b = T.seq; }
    else { T.seq = 4 + (tt - 512); T.t0 = 0; T.first = 1; T.last = 1; T.samp = 1; T.b = tt - 512; }
    return T;
}
__device__ __forceinline__ void ld8f(const float* s, float (&f)[8]) { const f32x4 a = *(const f32x4*)s, b = *(const f32x4*)(s + 4); f[0] = a.x; f[1] = a.y; f[2] = a.z; f[3] = a.w; f[4] = b.x; f[5] = b.y; f[6] = b.z; f[7] = b.w; }

__device__ __forceinline__ void mix_a(const Lay& L, const Tile& T, int tid) {
    asm volatile("" : "+v"(tid));
    const int c0 = (tid & 31) * 8, tq = tid >> 5;
    const bf16* ub = L.U + (size_t)(T.row0 + tq * 4) * UC + c0;
    const bool hist = T.first && tq == 0;
    v4u rv[6], rb[4];
#pragma unroll
    for (int jj = 0; jj < 6; ++jj) rv[jj] = (jj >= 2 || !hist) ? __builtin_nontemporal_load((const v4u*)(ub + (jj - 2) * UC + C_V)) : (v4u){0u, 0u, 0u, 0u};
#pragma unroll
    for (int j = 0; j < 4; ++j) rb[j] = __builtin_nontemporal_load((const v4u*)(ub + j * UC + C_ABG));
    float w[3][8];
#pragma unroll
    for (int k = 0; k < 3; ++k) ld8f(L.caw + k * 256 + c0, w[k]);
    float v[6][8];
#pragma unroll
    for (int jj = 0; jj < 6; ++jj) unpack8(rv[jj], v[jj]);
    if (hist && T.samp) { ld8f(L.sta + ((size_t)T.b * 2 + 0) * 256 + c0, v[0]); ld8f(L.sta + ((size_t)T.b * 2 + 1) * 256 + c0, v[1]); }
#pragma unroll
    for (int j = 0; j < 4; ++j) {
        float fb[8], y[8]; unpack8(rb[j], fb);
#pragma unroll
        for (int i = 0; i < 8; ++i) y[i] = fb[i] * (w[0][i] * v[j][i] + w[1][i] * v[j + 1][i] + w[2][i] * v[j + 2][i]);
        *(v4u*)(L.Y + (size_t)(T.row0 + tq * 4 + j) * D + c0) = pack8(y);
    }
    if (T.last && tq == 15) {
#pragma unroll
        for (int j2 = 0; j2 < 2; ++j2) {
            float* dst = L.out + (T.samp ? O_NAS + ((size_t)(L.l * 32 + T.b) * 2 + j2) * 256 : O_NAP + ((size_t)(L.l * 4 + T.b) * 2 + j2) * 256) + c0;
            *(f32x4*)dst = (f32x4){v[4 + j2][0], v[4 + j2][1], v[4 + j2][2], v[4 + j2][3]};
            *(f32x4*)(dst + 4) = (f32x4){v[4 + j2][4], v[4 + j2][5], v[4 + j2][6], v[4 + j2][7]};
        }
    }
}

__device__ __forceinline__ void mix_b(const Lay& L, const Tile& T, int tid, LAS unsigned char* lds) {
    asm volatile("" : "+v"(tid));
    LAS float* G = (LAS float*)lds;
    LAS float* red = (LAS float*)(lds + 98304);
    LAS bf16* SB = (LAS bf16*)(lds + 100352);
    LAS float* stat = (LAS float*)(lds + 133632);
    const int c = tid & 255, th = tid >> 8, lane = tid & 63, wq = (tid >> 6) & 3;
    float w[31];
    {
        v4u rg[6], rs[4];
#pragma unroll
        for (int k = 0; k < 6; ++k) {
            const int i = tid + 512 * k, r = i >> 5, c0 = (i & 31) * 8, tt = r - 30;
            rg[k] = (i < 94 * 32 && (tt >= 0 || !T.first)) ? __builtin_nontemporal_load((const v4u*)(L.U + (size_t)(T.row0 + tt) * UC + C_GLU + c0)) : (v4u){0u, 0u, 0u, 0u};
        }
#pragma unroll
        for (int k = 0; k < 4; ++k) { const int i = tid + 512 * k, r = i >> 5, c0 = (i & 31) * 8; rs[k] = __builtin_nontemporal_load((const v4u*)(L.U + (size_t)(T.row0 + r) * UC + C_SBG + c0)); }
#pragma unroll
        for (int k = 0; k < 31; ++k) w[k] = L.cbw[k * 256 + c];
#pragma unroll
        for (int k = 0; k < 6; ++k) {
            const int i = tid + 512 * k, r = i >> 5, c0 = (i & 31) * 8, tt = r - 30;
            if (i < 94 * 32) {
                float g8[8]; unpack8(rg[k], g8);
                if (tt < 0 && T.first && T.samp) ld8f(L.stb + ((size_t)T.b * 30 + r) * 256 + c0, g8);
                *(LAS f32x4*)(G + r * 256 + c0) = (f32x4){g8[0], g8[1], g8[2], g8[3]};
                *(LAS f32x4*)(G + r * 256 + c0 + 4) = (f32x4){g8[4], g8[5], g8[6], g8[7]};
            }
        }
#pragma unroll
        for (int k = 0; k < 4; ++k) { const int i = tid + 512 * k; *(LAS v4u*)(SB + i * 8) = rs[k]; }
    }
    __syncthreads();
    const float bias = L.cbb[c];
    float z[4][8];
    {
        float g[62];
#pragma unroll
        for (int i = 0; i < 62; ++i) g[i] = G[(th * 32 + i) * 256 + c];
#pragma unroll
        for (int ch = 0; ch < 4; ++ch)
#pragma unroll
            for (int j = 0; j < 8; ++j) {
                float a = bias;
#pragma unroll
                for (int k = 0; k < 31; ++k) a += w[k] * g[ch * 8 + j + k];
                z[ch][j] = a;
            }
    }
    const bool b5 = (lane & 32) != 0, b4 = (lane & 16) != 0, b3 = (lane & 8) != 0;
#pragma unroll
    for (int ch = 0; ch < 4; ++ch) {
        const int tb = th * 32 + ch * 8;
        float r1[4], r2[4];
#pragma unroll
        for (int i = 0; i < 4; ++i) {
            const float za = z[ch][i], zb = z[ch][4 + i];
            const float k1 = b5 ? zb : za, s1 = b5 ? za : zb;
            r1[i] = k1 + __shfl_xor(s1, 32);
            const float k2 = b5 ? zb * zb : za * za, s2 = b5 ? za * za : zb * zb;
            r2[i] = k2 + __shfl_xor(s2, 32);
        }
        float q1[2], q2[2];
#pragma unroll
        for (int i = 0; i < 2; ++i) {
            const float k1 = b4 ? r1[2 + i] : r1[i], s1 = b4 ? r1[i] : r1[2 + i];
            q1[i] = k1 + __shfl_xor(s1, 16);
            const float k2 = b4 ? r2[2 + i] : r2[i], s2 = b4 ? r2[i] : r2[2 + i];
            q2[i] = k2 + __shfl_xor(s2, 16);
        }
        float d1 = (b3 ? q1[1] : q1[0]) + __shfl_xor(b3 ? q1[0] : q1[1], 8);
        float d2 = (b3 ? q2[1] : q2[0]) + __shfl_xor(b3 ? q2[0] : q2[1], 8);
        d1 += __shfl_xor(d1, 4); d1 += __shfl_xor(d1, 2); d1 += __shfl_xor(d1, 1);
        d2 += __shfl_xor(d2, 4); d2 += __shfl_xor(d2, 2); d2 += __shfl_xor(d2, 1);
        if ((lane & 7) == 0) { red[(tb + (lane >> 3)) * 8 + wq * 2] = d1; red[(tb + (lane >> 3)) * 8 + wq * 2 + 1] = d2; }
    }
    __syncthreads();
    if (T.last) {
        float* dst = L.out + (T.samp ? O_NBS + (size_t)(L.l * 32 + T.b) * 30 * 256 : O_NBP + (size_t)(L.l * 4 + T.b) * 30 * 256);
        for (int i = tid; i < 30 * 256; i += 512) dst[i] = G[64 * 256 + i];
    }
    if (tid < 64) {
        const f32x4 ra = *(LAS f32x4*)(red + tid * 8), rb = *(LAS f32x4*)(red + tid * 8 + 4);
        const float S1 = (ra.x + ra.z) + (rb.x + rb.z), S2 = (ra.y + ra.w) + (rb.y + rb.w);
        const float mu = S1 * (1.f / 256.f), var = S2 * (1.f / 256.f) - mu * mu;
        stat[tid * 2] = mu; stat[tid * 2 + 1] = rsqrtf(fmaxf(var, 0.f) + EPS);
    }
    const float lg = L.lng[c], lb = L.lnb[c];
    __syncthreads();
    {
        typedef float f32x2v __attribute__((ext_vector_type(2)));
        f32x2v st[4][8]; float gt[4][8];
#pragma unroll
        for (int ch = 0; ch < 4; ++ch)
#pragma unroll
            for (int j = 0; j < 8; ++j) { const int t = th * 32 + ch * 8 + j; st[ch][j] = *(const LAS f32x2v*)(stat + t * 2); gt[ch][j] = bf1(SB[t * 256 + c]); }
#pragma unroll
        for (int ch = 0; ch < 4; ++ch)
#pragma unroll
            for (int j = 0; j < 8; ++j) {
                const float zn = (z[ch][j] - st[ch][j].x) * (st[ch][j].y * lg) + lb;
                gt[ch][j] = silu(zn) * gt[ch][j];
            }
#pragma unroll
        for (int ch = 0; ch < 4; ++ch)
#pragma unroll
            for (int j = 0; j < 8; ++j) { const int t = th * 32 + ch * 8 + j; SB[t * 256 + c] = (bf16)(cvtpk(gt[ch][j], 0.f) & 0xffffu); }
    }
    __syncthreads();
#pragma unroll
    for (int k = 0; k < 4; ++k) { const int i = tid + 512 * k, r = i >> 5, c0 = (i & 31) * 8; *(v4u*)(L.Y + (size_t)(T.row0 + r) * D + 256 + c0) = *(LAS v4u*)(SB + i * 8); }
    __syncthreads();
}

__device__ __forceinline__ void mix_c(const Lay& L, const Tile& T, int tid, LAS unsigned char* lds) {
    asm volatile("" : "+v"(tid));
    LAS float* P = (LAS float*)lds;
    LAS bf16* Dm = (LAS bf16*)(lds + 81920);
    const int wave = tid >> 6, lane = tid & 63, mg = wave & 3, mth = wave >> 2, mr = lane & 15, mq = lane >> 4;
    v2u cg2[4][2];
    bf16x8 af[4][2];
    {
        v4u rg[5];
#pragma unroll
        for (int k = 0; k < 5; ++k) {
            const int i = tid + 512 * k, r = i >> 5, c0 = (i & 31) * 8, tt = r - 15;
            rg[k] = (i < 79 * 32 && (tt >= 0 || !T.first)) ? __builtin_nontemporal_load((const v4u*)(L.U + (size_t)(T.row0 + tt) * UC + C_CU + c0)) : (v4u){0u, 0u, 0u, 0u};
        }
#pragma unroll
        for (int mt = 0; mt < 4; ++mt)
#pragma unroll
            for (int nt = 0; nt < 2; ++nt) cg2[mt][nt] = *(const v2u*)(L.U + (size_t)(T.row0 + mth * 32 + nt * 16 + mr) * UC + C_SCG + mg * 64 + mt * 16 + 4 * mq);
#pragma unroll
        for (int mt = 0; mt < 4; ++mt)
#pragma unroll
            for (int kk = 0; kk < 2; ++kk) af[mt][kk] = *(const bf16x8*)(L.PWT + ((size_t)(mg * 64 + mt * 16 + mr)) * 64 + kk * 32 + mq * 8);
#pragma unroll
        for (int k = 0; k < 5; ++k) {
            const int i = tid + 512 * k, r = i >> 5, c0 = (i & 31) * 8, tt = r - 15;
            if (i < 79 * 32) {
                float g8[8]; unpack8(rg[k], g8);
                if (tt < 0 && T.first && T.samp) ld8f(L.stp + ((size_t)T.b * 15 + r) * 256 + c0, g8);
                *(LAS f32x4*)(P + r * 256 + c0) = (f32x4){g8[0], g8[1], g8[2], g8[3]};
                *(LAS f32x4*)(P + r * 256 + c0 + 4) = (f32x4){g8[4], g8[5], g8[6], g8[7]};
            }
        }
    }
    __syncthreads();
    {
        const int c = tid & 255, th = tid >> 8, g = __builtin_amdgcn_readfirstlane(c >> 6), w = 2 << g;
        const LAS float* Pc = P + th * 32 * 256 + c;
        float x[47], cur[32];
#pragma unroll
        for (int i = 0; i < 47; ++i) x[i] = Pc[i * 256];
#pragma unroll
        for (int i = 0; i < 32; ++i) cur[i] = x[15 + i];
#pragma unroll
        for (int i = 46; i >= 1; --i) x[i] += x[i - 1];
        if (g >= 1) {
#pragma unroll
            for (int i = 46; i >= 3; --i) x[i] += x[i - 2];
        }
        if (g >= 2) {
#pragma unroll
            for (int i = 46; i >= 7; --i) x[i] += x[i - 4];
        }
        if (g >= 3) {
#pragma unroll
            for (int i = 46; i >= 15; --i) x[i] += x[i - 8];
        }
        const int pos1 = (T.samp ? 1024 : 0) + T.t0 + th * 32 + 1;
        const float rw = __builtin_amdgcn_rcpf((float)w);
#pragma unroll
        for (int i = 0; i < 32; ++i) {
            const float rc = (pos1 + i >= w) ? rw : __builtin_amdgcn_rcpf((float)(pos1 + i));
            const float d = x[15 + i] * rc - cur[i];
            Dm[(th * 32 + i) * 264 + c] = (bf16)(cvtpk(d, 0.f) & 0xffffu);
        }
    }
    __syncthreads();
    if (T.last) {
        float* dst = L.out + (T.samp ? O_NPS + (size_t)(L.l * 32 + T.b) * 15 * 256 : O_NPP + (size_t)(L.l * 4 + T.b) * 15 * 256);
        for (int i = tid; i < 15 * 256; i += 512) dst[i] = P[64 * 256 + i];
    }
    {
        bf16x8 bfr[2][2];
#pragma unroll
        for (int nt = 0; nt < 2; ++nt)
#pragma unroll
            for (int kk = 0; kk < 2; ++kk) bfr[nt][kk] = *(const LAS bf16x8*)(Dm + (mth * 32 + nt * 16 + mr) * 264 + mg * 64 + kk * 32 + mq * 8);
        f32x4 acc[4][2];
#pragma unroll
        for (int mt = 0; mt < 4; ++mt)
#pragma unroll
            for (int nt = 0; nt < 2; ++nt) {
                f32x4 a = (f32x4){0.f, 0.f, 0.f, 0.f};
                a = __builtin_amdgcn_mfma_f32_16x16x32_bf16(af[mt][0], bfr[nt][0], a, 0, 0, 0);
                a = __builtin_amdgcn_mfma_f32_16x16x32_bf16(af[mt][1], bfr[nt][1], a, 0, 0, 0);
                acc[mt][nt] = a;
            }
#pragma unroll
        for (int mt = 0; mt < 4; ++mt) {
            const int chn = mg * 64 + mt * 16 + 4 * mq;
            const f32x4 pb = *(const f32x4*)(L.pbias + chn), ps = *(const f32x4*)(L.pscale + chn);
#pragma unroll
            for (int nt = 0; nt < 2; ++nt) {
                const size_t row = (size_t)(T.row0 + mth * 32 + nt * 16 + mr);
                const float y0 = (acc[mt][nt][0] + pb.x) * ps.x * bflo(cg2[mt][nt].x), y1 = (acc[mt][nt][1] + pb.y) * ps.y * bfhi(cg2[mt][nt].x);
                const float y2 = (acc[mt][nt][2] + pb.z) * ps.z * bflo(cg2[mt][nt].y), y3 = (acc[mt][nt][3] + pb.w) * ps.w * bfhi(cg2[mt][nt].y);
                v2u o; o.x = cvtpk(y0, y1); o.y = cvtpk(y2, y3);
                *(v2u*)(L.Y + row * D + 512 + chn) = o;
            }
        }
    }
    __syncthreads();
}

__device__ __forceinline__ void mix_x(const Lay& L, const Tile& T, int hp, int tid, LAS unsigned char* lds) {
    asm volatile("" : "+v"(tid));
    const int wave = __builtin_amdgcn_readfirstlane(tid >> 6), lane = tid & 63, hl = wave >> 2, h = hp * 2 + hl, nt = wave & 3, r = lane & 15, q = lane >> 4;
    {
        const char* ksrc = (const char*)(L.KB + ((size_t)T.seq * 4 + hp * 2) * 16384);
        const char* vsrc = (const char*)(L.VT + ((size_t)T.seq * 4 + hp * 2) * 16384);
#pragma unroll
        for (int i = 0; i < 8; ++i) {
            const int cb = i * 8 + wave;
            const int dst = (cb >> 5) * 65536 + (cb & 31) * 1024;
            __builtin_amdgcn_global_load_lds((const unsigned*)(ksrc + (size_t)cb * 1024 + lane * 16), (LAS unsigned*)(lds + dst), 16, 0, 0);
            __builtin_amdgcn_global_load_lds((const unsigned*)(vsrc + (size_t)cb * 1024 + lane * 16), (LAS unsigned*)(lds + dst + 32768), 16, 0, 0);
        }
    }
    const size_t row = (size_t)(T.row0 + nt * 16 + r);
    bf16x8 qf[2];
#pragma unroll
    for (int kk = 0; kk < 2; ++kk) qf[kk] = *(const bf16x8*)(L.U + row * UC + C_Q + h * 64 + kk * 32 + q * 8);
    v2u xg[4];
#pragma unroll
    for (int dt = 0; dt < 4; ++dt) xg[dt] = *(const v2u*)(L.U + row * UC + C_SXG + h * 64 + dt * 16 + 4 * q);
    asm volatile("s_waitcnt vmcnt(0)" ::: "memory");
    __syncthreads();
    const LAS bf16x8* Kf = (const LAS bf16x8*)(lds + hl * 65536) + lane;
    const LAS bf16x8* Vf = (const LAS bf16x8*)(lds + hl * 65536 + 32768) + lane;
    f32x4 s[16];
#pragma unroll
    for (int mt = 0; mt < 16; ++mt) {
        const bf16x8 k0 = Kf[(mt * 2) * 64], k1 = Kf[(mt * 2 + 1) * 64];
        f32x4 a = (f32x4){0.f, 0.f, 0.f, 0.f};
        a = __builtin_amdgcn_mfma_f32_16x16x32_bf16(k0, qf[0], a, 0, 0, 0);
        a = __builtin_amdgcn_mfma_f32_16x16x32_bf16(k1, qf[1], a, 0, 0, 0);
        s[mt] = a;
    }
    float mx = -3.0e38f;
#pragma unroll
    for (int mt = 0; mt < 16; ++mt) mx = fmaxf(mx, fmaxf(fmaxf(s[mt][0], s[mt][1]), fmaxf(s[mt][2], s[mt][3])));
    mx = fmaxf(mx, __shfl_xor(mx, 16)); mx = fmaxf(mx, __shfl_xor(mx, 32));
    float sum = 0.f;
#pragma unroll
    for (int mt = 0; mt < 16; ++mt)
#pragma unroll
        for (int j = 0; j < 4; ++j) { const float pv = __builtin_amdgcn_exp2f(s[mt][j] - mx); s[mt][j] = pv; sum += pv; }
    sum += __shfl_xor(sum, 16); sum += __shfl_xor(sum, 32);
    const float inv = 1.0f / sum;
    f32x4 o[4];
#pragma unroll
    for (int dt = 0; dt < 4; ++dt) o[dt] = (f32x4){0.f, 0.f, 0.f, 0.f};
#pragma unroll
    for (int mp = 0; mp < 8; ++mp) {
        v4u pk; pk.x = cvtpk(s[2 * mp][0], s[2 * mp][1]); pk.y = cvtpk(s[2 * mp][2], s[2 * mp][3]);
        pk.z = cvtpk(s[2 * mp + 1][0], s[2 * mp + 1][1]); pk.w = cvtpk(s[2 * mp + 1][2], s[2 * mp + 1][3]);
        const bf16x8 pf = __builtin_bit_cast(bf16x8, pk);
#pragma unroll
        for (int dt = 0; dt < 4; ++dt) o[dt] = __builtin_amdgcn_mfma_f32_16x16x32_bf16(Vf[(mp * 4 + dt) * 64], pf, o[dt], 0, 0, 0);
    }
#pragma unroll
    for (int dt = 0; dt < 4; ++dt) {
        const float y0 = o[dt][0] * inv * bflo(xg[dt].x), y1 = o[dt][1] * inv * bfhi(xg[dt].x);
        const float y2 = o[dt][2] * inv * bflo(xg[dt].y), y3 = o[dt][3] * inv * bfhi(xg[dt].y);
        v2u ov; ov.x = cvtpk(y0, y1); ov.y = cvtpk(y2, y3);
        *(v2u*)(L.Y + row * D + 768 + h * 64 + dt * 16 + 4 * q) = ov;
    }
    __syncthreads();
}

#define XB_TMO      128
#define XB_XCNT(j)  (256  + 64 * (j))
#define XB_XSUB(j)  (1280 + 64 * (j))
#define XB_XGEN(j)  (2304 + 64 * (j))
#define XB_TOP      3328
#define XB_TOPGEN   3392
#define XCD_BAR_WORDS 3456
#define XB_SPIN_CAP (1u << 18)

__device__ __forceinline__ unsigned xb_ld(unsigned* p)              { return __hip_atomic_load(p, __ATOMIC_RELAXED, __HIP_MEMORY_SCOPE_AGENT); }
__device__ __forceinline__ unsigned xb_add(unsigned* p, unsigned v) { return __hip_atomic_fetch_add(p, v, __ATOMIC_RELAXED, __HIP_MEMORY_SCOPE_AGENT); }
__device__ __forceinline__ unsigned xb_xcc_id() { return (unsigned)__builtin_amdgcn_s_getreg((3 << 11) | 20) & 0xFu; }
#define XB_SPIN(cond, bar) do { unsigned _sp = 0; while (cond) { __builtin_amdgcn_s_sleep(1); \
    if ((++_sp & 255u) == 0u) { if (xb_ld(&(bar)[XB_TMO])) break; if (_sp > XB_SPIN_CAP) { atomicAdd(&(bar)[XB_TMO], 1u); break; } } } } while (0)

struct XcdBarrier {
    unsigned* bar; unsigned x;
    volatile LAS unsigned* st;
};

__device__ __forceinline__ XcdBarrier xcd_barrier_post(unsigned* bar, volatile LAS unsigned* st) {
    XcdBarrier b; b.bar = bar; b.x = xb_xcc_id(); b.st = st;
    if (threadIdx.x == 0) (void)xb_add(&bar[XB_XCNT(b.x)], 1u);
    return b;
}
__device__ __forceinline__ void xcd_barrier_complete(unsigned* bar, unsigned x, unsigned& nloc, unsigned& nx) {
    const unsigned G = gridDim.x * gridDim.y * gridDim.z;
    unsigned sum, cnt, mine, sp = 0u;
    for (;;) {
        sum = 0u; cnt = 0u; mine = 0u;
#pragma unroll
        for (unsigned j = 0; j < 16; ++j) { const unsigned c = xb_ld(&bar[XB_XCNT(j)]); sum += c; cnt += (c > 0u) ? 1u : 0u; mine = (j == x) ? c : mine; }
        if (sum == G) break;
        __builtin_amdgcn_s_sleep(1);
        if ((++sp & 255u) == 0u) { if (xb_ld(&bar[XB_TMO])) break; if (sp > XB_SPIN_CAP) { atomicAdd(&bar[XB_TMO], 1u); break; } }
    }
    nloc = mine > 0u ? mine : 1u; nx = cnt > 0u ? cnt : 1u;
}

__device__ __forceinline__ void xcd_barrier(const XcdBarrier& b) {
    asm volatile("s_waitcnt vmcnt(0)" ::: "memory");
    __syncthreads();
    if (threadIdx.x == 0) {
        unsigned* bar = b.bar;
        __builtin_amdgcn_s_waitcnt(0);
        unsigned nloc = b.st[0], nx = b.st[1];
        if (nloc == 0u) { xcd_barrier_complete(bar, b.x, nloc, nx); b.st[0] = nloc; b.st[1] = nx; }
        const unsigned old = xb_add(&bar[XB_XSUB(b.x)], 1u);
        const unsigned gen = old / nloc;
        if (old + 1u == (gen + 1u) * nloc) {
            __builtin_amdgcn_fence(__ATOMIC_RELEASE, "agent");
            asm volatile("s_waitcnt vmcnt(0)" ::: "memory");
            const unsigned og = xb_add(&bar[XB_TOP], 1u);
            const unsigned tg = og / nx;
            if (og + 1u == (tg + 1u) * nx) xb_add(&bar[XB_TOPGEN], 1u);
            else XB_SPIN(xb_ld(&bar[XB_TOPGEN]) == tg, bar);
            __builtin_amdgcn_fence(__ATOMIC_ACQUIRE, "agent");
            xb_add(&bar[XB_XGEN(b.x)], 1u);
            asm volatile("s_waitcnt vmcnt(0)" ::: "memory");
        } else {
            XB_SPIN(xb_ld(&bar[XB_XGEN(b.x)]) == gen, bar);
            __builtin_amdgcn_fence(__ATOMIC_ACQUIRE, "agent");
            asm volatile("s_waitcnt vmcnt(0)" ::: "memory");
        }
    }
    __syncthreads();
}

#define WIN ((bf16*)(ws + WS_WIN))
#define WOUT ((bf16*)(ws + WS_WOUT))
#define WMEM ((bf16*)(ws + WS_WMEM))
#define W_PWT ((bf16*)(ws + WS_PWT))
#define RSM ((float*)(ws + WS_RSM))
#define SSPA ((float*)(ws + WS_SSPA))
#define SSPB ((float*)(ws + WS_SSPB))
#define MNB ((bf16*)(ws + WS_MNB))
#define W_KB ((bf16*)(ws + WS_KB))
#define W_VT ((bf16*)(ws + WS_VT))
#define XB ((bf16*)(ws + WS_XB))
#define YB ((bf16*)(ws + WS_Y))
#define UB ((bf16*)(ws + WS_U))
#define PHASE_WS __attribute__((address_space(1))) unsigned char* wsg_ = (__attribute__((address_space(1))) unsigned char*)p.ws; asm volatile("" : "+s"(wsg_)); unsigned char* ws = (unsigned char*)wsg_;
__global__ void __launch_bounds__(512, 2) hymba_fwd(Params p) {
    extern __shared__ __attribute__((aligned(16))) unsigned char lds_raw[];
    LAS unsigned char* lds = (LAS unsigned char*)lds_raw;
    cg::grid_group grid = cg::this_grid();
    const int tid = threadIdx.x, lane = tid & 63, wave = __builtin_amdgcn_readfirstlane(tid >> 6);
    const int G = gridDim.x, bx = blockIdx.x;
    if (tid < 2) ((LAS unsigned*)(lds + 133120))[tid] = 0u;
    __syncthreads();

    {
        PHASE_WS
        if (bx == 0) for (int i = tid; i < 4096; i += 512) ((unsigned*)(ws + WS_CTL))[i] = 0u;
        const float* xp = p.in[0]; const float* xs = p.in[1];
        LAS float* scr = (LAS float*)(lds + wave * 16384);
        const int gw = bx * 8 + wave, NGW = G * 8;
        constexpr int I_IN = 16 * 88, I_OUT = 16 * 32, I_MEM = 16 * 8, I_L = I_IN + I_OUT + 2 * I_MEM;
        for (int it = gw; it < 2 * I_L; it += NGW) {
            const int l = it / I_L; int r = it % I_L;
            if (r < I_IN) { transpose_item(p.in[9] + (size_t)l * D * NC, D, NC, WIN + (size_t)l * NC * D, 0, p.in[8] + l * D, scr, r, lane, true); continue; } r -= I_IN;
            if (r < I_OUT) { transpose_item(p.in[21] + (size_t)l * D * D, D, D, WOUT + (size_t)l * D * D, 0, nullptr, scr, r, lane); continue; } r -= I_OUT;
            if (r < I_MEM) { transpose_item(p.in[19] + (size_t)l * D * 256, D, 256, WMEM, l * 512, p.in[18] + l * D, scr, r, lane); continue; } r -= I_MEM;
            transpose_item(p.in[20] + (size_t)l * D * 256, D, 256, WMEM, l * 512 + 256, p.in[18] + l * D, scr, r, lane);
        }
        for (int m0 = gw; m0 < M; m0 += 4 * NGW) {
            f32x4 v[4][4]; float ss[4];
#pragma unroll
            for (int u = 0; u < 4; ++u) {
                const int m = m0 + u * NGW;
                const float* xr = m < NPR ? xp + (size_t)m * D : xs + (size_t)(m - NPR) * D;
#pragma unroll
                for (int j = 0; j < 4; ++j) v[u][j] = (m < M) ? __builtin_nontemporal_load((const f32x4*)xr + lane + 64 * j) : (f32x4){0.f, 0.f, 0.f, 0.f};
            }
#pragma unroll
            for (int u = 0; u < 4; ++u) {
                float a = 0.f;
#pragma unroll
                for (int j = 0; j < 4; ++j) a += (v[u][j].x * v[u][j].x + v[u][j].y * v[u][j].y) + (v[u][j].z * v[u][j].z + v[u][j].w * v[u][j].w);
                ss[u] = wave_sum(a);
            }
#pragma unroll
            for (int u = 0; u < 4; ++u) {
                const int m = m0 + u * NGW;
                if (m < M) {
                    v2u* o8 = (v2u*)(XB + (size_t)m * D) + lane;
#pragma unroll
                    for (int j = 0; j < 4; ++j) { v2u w; w.x = cvtpk(v[u][j].x, v[u][j].y); w.y = cvtpk(v[u][j].z, v[u][j].w); o8[64 * j] = w; }
                    if (lane < 16) SSPA[(size_t)m * 16 + lane] = (lane == 0) ? ss[u] : 0.f;
                }
            }
        }
        for (int m = gw; m < 1024; m += NGW) {
            const float ss = row_to_bf16(p.in[2] + (size_t)m * D, MNB + (size_t)m * D, lane);
            if (lane == 0) RSM[m] = rsqrtf(ss * (1.f / 1024.f) + EPS);
        }
        for (int i8 = bx * 512 + tid; i8 < 2 * 32 * 65536 / 8; i8 += G * 512) {
            const size_t i = (size_t)i8 * 8; const int l = (int)(i >> 21), b = (int)((i >> 16) & 31), mem = (int)((i >> 8) & 255), h = (int)((i >> 6) & 3), d = (int)(i & 63);
            const f32x4 a = *(const f32x4*)(p.in[6] + i), c = *(const f32x4*)(p.in[6] + i + 4);
            v4u o; o.x = cvtpk(a.x, a.y); o.y = cvtpk(a.z, a.w); o.z = cvtpk(c.x, c.y); o.w = cvtpk(c.z, c.w);
            const int mt = (mem >> 5) * 2 + ((mem >> 2) & 1), r = ((mem >> 3) & 3) * 4 + (mem & 3), kk = d >> 5, q = (d >> 3) & 3;
            *(v4u*)(W_KB + ((size_t)((l * NSEQ + 4 + b) * 4 + h) * 32 + mt * 2 + kk) * 512 + (q * 16 + r) * 8) = o;
        }
        for (int it = gw; it < 8192; it += NGW) {
            const int mg = it & 31, h = (it >> 5) & 3, b = (it >> 7) & 31, l = it >> 12;
            float f[8];
#pragma unroll
            for (int i = 0; i < 8; ++i) f[i] = p.in[7][(((size_t)(l * 32 + b) * 256 + mg * 8 + i) * 4 + h) * 64 + lane];
            const int mp = mg >> 2, q = mg & 3, dt = lane >> 4, r = lane & 15;
            *(v4u*)(W_VT + ((size_t)((l * NSEQ + 4 + b) * 4 + h) * 32 + mp * 4 + dt) * 512 + (q * 16 + r) * 8) = pack8(f);
        }
        for (int i = bx * 512 + tid; i < 32768; i += G * 512) {
            const int c = i & 63, e = (i >> 6) & 63, lg = i >> 12;
            W_PWT[i] = (bf16)(cvtpk(p.in[15][((size_t)lg * 64 + c) * 64 + e], 0.f) & 0xffffu);
        }
    }
    grid.sync();
    const XcdBarrier bar = xcd_barrier_post((unsigned*)(p.ws + WS_CTL), (volatile LAS unsigned*)(lds + 133120));

    {
        PHASE_WS
        pg8::Gemm g{MNB, WMEM, 1024, 1024, D}; pg8::StaticOrder S; S.init(1024, 1024, G, G - 1 - bx);
        EpiKV E{RSM, p.out, W_KB, W_VT};
        pg8::gemm_phase<EpiKV, pg8::StaticOrder, false, true>(lds, g, S, E);
    }

    for (int l = 0; l < 2; ++l) {
        {
            PHASE_WS
            pg8::Gemm g{XB, WIN + (size_t)l * NC * D, M, NC, D}; pg8::StaticOrder S; S.init(M, NC, G, bx);
            EpiU E{UB, l == 0 ? SSPA : SSPB};
            pg8::gemm_phase<EpiU, pg8::StaticOrder, true, true>(lds, g, S, E);
        }
        xcd_barrier(bar);
        {
            PHASE_WS
            Lay L;
            L.U = UB; L.Y = YB; L.KB = W_KB + (size_t)l * NSEQ * 65536; L.VT = W_VT + (size_t)l * NSEQ * 65536; L.PWT = W_PWT + (size_t)l * 16384;
            L.caw = p.in[10] + l * 768; L.cbw = p.in[11] + l * 31 * 256; L.cbb = p.in[12] + l * 256; L.lng = p.in[13] + l * 256; L.lnb = p.in[14] + l * 256;
            L.pbias = p.in[16] + l * 256; L.pscale = p.in[17] + l * 256;
            L.sta = p.in[3] + (size_t)l * 32 * 2 * 256; L.stb = p.in[4] + (size_t)l * 32 * 30 * 256; L.stp = p.in[5] + (size_t)l * 32 * 15 * 256;
            L.out = p.out; L.l = l;
            const int nk = (5 * NTILE - bx + G - 1) / G;
            for (int kk = 0; kk < nk; ++kk) {
                int k2 = kk + (bx >> 3) % nk; if (k2 >= nk) k2 -= nk;
                const int idx = bx + k2 * G;
                const int grp = idx / NTILE; const Tile T = mk_tile(idx % NTILE); const int hp = grp - 2;
                if (grp == 0) mix_b(L, T, tid, lds);
                else if (grp == 1) mix_c(L, T, tid, lds);
                else if (grp < 4) mix_x(L, T, hp, tid, lds);
                else mix_a(L, T, tid);
            }
        }
        xcd_barrier(bar);
        {
            PHASE_WS
            pg8::Gemm g{YB, WOUT + (size_t)l * D * D, M, D, D}; pg8::StaticOrder S; S.init(M, D, G, bx);
            EpiX E{XB, l == 0 ? SSPB : SSPA, XB};
            pg8::gemm_phase<EpiX, pg8::StaticOrder, true, true>(lds, g, S, E);
        }
        xcd_barrier(bar);
    }
    {
        PHASE_WS
        const int gw = bx * 8 + wave, NGW = G * 8;
        const float* gf = p.in[22];
        f32x4 gv[4];
#pragma unroll
        for (int j = 0; j < 4; ++j) gv[j] = ((const f32x4*)gf)[lane + 64 * j];
        for (int m0 = gw; m0 < M; m0 += 4 * NGW) {
            v2u xv[4][4]; f32x4 sq[4];
#pragma unroll
            for (int u = 0; u < 4; ++u) {
                const int m = min(m0 + u * NGW, M - 1);
                sq[u] = *((const f32x4*)(SSPA + (size_t)m * 16) + (lane & 3));
                const v2u* xr = (const v2u*)(XB + (size_t)m * D) + lane;
#pragma unroll
                for (int j = 0; j < 4; ++j) xv[u][j] = __builtin_nontemporal_load(xr + 64 * j);
            }
#pragma unroll
            for (int u = 0; u < 4; ++u) {
                const int m = m0 + u * NGW;
                float t = (sq[u].x + sq[u].y) + (sq[u].z + sq[u].w);
                t += __shfl_xor(t, 1); t += __shfl_xor(t, 2);
                const float rstd = rsqrtf(t * (1.f / 1024.f) + EPS);
                if (m < M) {
                    f32x4* yr = (f32x4*)(p.out + (size_t)m * D) + lane;
#pragma unroll
                    for (int j = 0; j < 4; ++j) { const f32x4 v = (f32x4){bflo(xv[u][j].x), bfhi(xv[u][j].x), bflo(xv[u][j].y), bfhi(xv[u][j].y)}; __builtin_nontemporal_store(v * rstd * gv[j], yr + 64 * j); }
                }
            }
        }
    }
}

extern "C" void kernel_launch(void* const* d_in, const int* in_sizes, int n_in, void* d_out, int out_size, void* d_ws, size_t ws_size, hipStream_t stream) {
    static int grid_blocks = 0;
    if (grid_blocks == 0) {
        if (n_in != 23 || (size_t)out_size != O_END || ws_size < WS_END) { fprintf(stderr, "kernel_launch: unexpected shapes (n_in %d out %d ws %zu)\n", n_in, out_size, ws_size); grid_blocks = -1; return; }
        int dev = 0, cus = 0, per_cu = 0;
        hipGetDevice(&dev);
        hipDeviceGetAttribute(&cus, hipDeviceAttributeMultiprocessorCount, dev);
        if (hipFuncSetAttribute((const void*)hymba_fwd, hipFuncAttributeMaxDynamicSharedMemorySize, LDS_BYTES) != hipSuccess) { fprintf(stderr, "kernel_launch: hipFuncSetAttribute failed\n"); grid_blocks = -1; return; }
        if (hipOccupancyMaxActiveBlocksPerMultiprocessor(&per_cu, (const void*)hymba_fwd, 512, LDS_BYTES) != hipSuccess || per_cu < 1) { fprintf(stderr, "kernel_launch: occupancy query says %d\n", per_cu); per_cu = 1; }
        (void)hipGetLastError();
        grid_blocks = cus * 1;
    }
    if (grid_blocks < 0) return;
    Params p{};
    for (int i = 0; i < 23; ++i) p.in[i] = (const float*)d_in[i];
    p.out = (float*)d_out; p.ws = (unsigned char*)d_ws;
    void* args[] = {&p};
    hipError_t e = hipLaunchCooperativeKernel((const void*)hymba_fwd, dim3(grid_blocks), dim3(512), args, LDS_BYTES, stream);
    if (e != hipSuccess) fprintf(stderr, "cooperative launch failed: %s (grid %d)\n", hipGetErrorString(e), grid_blocks);
}
```

```cpp
#include <hip/hip_runtime.h>
#include <hip/hip_cooperative_groups.h>
#include <cstdio>
#include <cstdint>
namespace cg = cooperative_groups;
namespace pg8 {
#define PG8_LAS __attribute__((address_space(3)))
typedef unsigned short bf16_t;
typedef short bf16x8 __attribute__((ext_vector_type(8)));
typedef float f32x4 __attribute__((ext_vector_type(4)));
typedef unsigned u32x4 __attribute__((ext_vector_type(4)));
constexpr int BM = 256, BK = 64, HALF = 128, HTB = HALF * BK * 2  , STAGE_BYTES = 8 * HTB, NXCD = 8, WGM = 8;

__host__ __device__ __forceinline__ int lds_byte(int r, int c) { const int st = (r >> 4) * 2 + (c >> 5), rr = r & 15, cc = c & 31, ob = rr * 64 + cc * 2; return st * 1024 + (ob ^ (((ob >> 9) & 1) << 5)); }
__host__ __device__ __forceinline__ void stage_rc(int b, int& R, int& C) { const int st = b / 1024, sb = b % 1024, swz = sb ^ (((sb >> 9) & 1) << 5); R = (st >> 1) * 16 + swz / 64; C = (st & 1) * 32 + (swz % 64) / 2; }
__host__ __device__ __forceinline__ int perm32(int rho) { const int n = rho >> 4, i = rho & 15; return 8 * (i >> 2) + 4 * n + (i & 3); }

struct Unit { int pm, pn; };
struct Gemm { const bf16_t* A; const bf16_t* Bt; int M, N, K; };

struct StaticOrder {
    int nM, nN, nwg, G, c;
    __host__ __device__ void init(int M, int N, int G_, int c_) { nM = M / BM; nN = N / BM; nwg = nM * nN; G = G_; c = c_; }
    __host__ __device__ bool next(int i, Unit& u) const {
        const long L = (long)i * G + c; if (L >= nwg) return false;
        int wgid = (int)L; { const int q = nwg / NXCD, r = nwg % NXCD, xcd = wgid % NXCD, off = wgid / NXCD; wgid = (xcd < r ? xcd * (q + 1) : r * (q + 1) + (xcd - r) * q) + off; }
        const int nig = WGM * nN, gid = wgid / nig, fm = gid * WGM, gsz = (nM - fm) < WGM ? (nM - fm) : WGM;
        u.pm = fm + ((wgid % nig) % gsz); u.pn = (wgid % nig) / gsz; return true;
    }
    __device__ __forceinline__ void a_ready(const Unit&) const {}
    __device__ __forceinline__ void done(const Unit&) const {}
};
__device__ __forceinline__ unsigned cvt_pk_bf16(float lo, float hi) { unsigned r; asm volatile("v_cvt_pk_bf16_f32 %0, %1, %2" : "=v"(r) : "v"(lo), "v"(hi)); return r; }
template <class Epi, class Sched, bool ALIGN_EPI = false, bool SP2 = false>
__device__ __forceinline__ void gemm_phase(PG8_LAS unsigned char* lds, const Gemm g, const Sched& S, const Epi& E) {
    const int tid = threadIdx.x, wid = __builtin_amdgcn_readfirstlane(tid >> 6), lane = tid & 63, wr = wid >> 2, wc = wid & 3, fr = lane & 15, fq = lane >> 4;
    const int K = g.K, nt = K / BK;
    unsigned voffA[2], voffB[2];
#pragma unroll
    for (int i = 0; i < 2; ++i) { int R, C; stage_rc(tid * 16 + i * 8192, R, C); const int Rb = Epi::PERM ? ((R & ~31) + perm32(R & 31)) : R;
        voffA[i] = (unsigned)(R * K + C) * 2u; voffB[i] = (unsigned)(Rb * K + C) * 2u; }
    const size_t kstep = (size_t)(BK * 2);
    const size_t hstep = (size_t)HALF * K * 2;
    const size_t tstep = 2 * hstep;
    const unsigned ldsw = (unsigned)wid * 1024u;
    const int aoff = lds_byte(wr * 64 + fr, fq * 8), boff = lds_byte(wc * 32 + fr, fq * 8);
#define PG8_SA(b, h) (((b) * 2 + (h)) * HTB)
#define PG8_SB(b, h) ((4 + (b) * 2 + (h)) * HTB)
#define PG8_STAGE(bufoff, gbase, voff) do { _Pragma("unroll") for (int _i = 0; _i < 2; ++_i) \
        __builtin_amdgcn_global_load_lds((const unsigned*)((const char*)(gbase) + (voff)[_i]), (PG8_LAS unsigned*)(lds + (bufoff) + ldsw + _i * 8192), 16, 0, 0); } while (0)
#define PG8_LDA(dst, b, h) do { _Pragma("unroll") for (int m = 0; m < 4; ++m) _Pragma("unroll") for (int k = 0; k < 2; ++k) dst[m][k] = *(const PG8_LAS bf16x8*)(lds + PG8_SA(b, h) + aoff + m * 2048 + k * 1024); } while (0)
#define PG8_LDB(dst, b, h) do { _Pragma("unroll") for (int n = 0; n < 2; ++n) _Pragma("unroll") for (int k = 0; k < 2; ++k) dst[n][k] = *(const PG8_LAS bf16x8*)(lds + PG8_SB(b, h) + boff + n * 2048 + k * 1024); } while (0)
#define PG8_MMA(ai, bj, At, Bt) do { __builtin_amdgcn_s_setprio(1); _Pragma("unroll") for (int m = 0; m < 4; ++m) _Pragma("unroll") for (int n = 0; n < 2; ++n) _Pragma("unroll") for (int k = 0; k < 2; ++k) \
        acc[ai][bj][m][n] = __builtin_amdgcn_mfma_f32_16x16x32_bf16(Bt[n][k], At[m][k], acc[ai][bj][m][n], 0, 0, 0); __builtin_amdgcn_s_setprio(0); } while (0)
#define PG8_WAIT_V(n) asm volatile("s_waitcnt vmcnt(" #n ")" ::: "memory")
#define PG8_WAIT_L(n) asm volatile("s_waitcnt lgkmcnt(" #n ")" ::: "memory")
#define PG8_BAR __builtin_amdgcn_s_barrier()
#define PG8_SCHED __builtin_amdgcn_sched_barrier(0)
    Unit cur, nxt; int ui = 0;
    if (!S.next(0, cur)) return;
    f32x4 acc[2][2][4][2];
#pragma unroll
    for (int a = 0; a < 2; ++a)
#pragma unroll
        for (int b = 0; b < 2; ++b)
#pragma unroll
            for (int m = 0; m < 4; ++m)
#pragma unroll
                for (int n = 0; n < 2; ++n) acc[a][b][m][n] = (f32x4){0.f, 0.f, 0.f, 0.f};
    bf16x8 At[4][2], B0[2][2], B1[2][2];
    const char* cA = (const char*)g.A + (size_t)cur.pm * tstep; const char* cB = (const char*)g.Bt + (size_t)cur.pn * tstep;
    S.a_ready(cur);
    if constexpr (SP2) {
        PG8_STAGE(PG8_SB(0, 0), cB, voffB); PG8_STAGE(PG8_SB(0, 1), cB + hstep, voffB); PG8_STAGE(PG8_SA(0, 0), cA, voffA); PG8_STAGE(PG8_SA(0, 1), cA + hstep, voffA);
        if (wr == 1) PG8_BAR;
        PG8_WAIT_V(2); PG8_BAR;
        PG8_STAGE(PG8_SB(1, 0), cB + kstep, voffB); PG8_STAGE(PG8_SA(1, 0), cA + kstep, voffA); PG8_STAGE(PG8_SB(1, 1), cB + hstep + kstep, voffB);
        PG8_WAIT_V(6); PG8_BAR;
    } else {
        PG8_STAGE(PG8_SB(0, 0), cB, voffB); PG8_STAGE(PG8_SA(0, 0), cA, voffA); PG8_STAGE(PG8_SB(0, 1), cB + hstep, voffB); PG8_STAGE(PG8_SA(0, 1), cA + hstep, voffA);
        if (wr == 1) PG8_BAR;
        PG8_WAIT_V(4); PG8_BAR;
        PG8_STAGE(PG8_SB(1, 0), cB + kstep, voffB); PG8_STAGE(PG8_SA(1, 0), cA + kstep, voffA); PG8_STAGE(PG8_SB(1, 1), cB + hstep + kstep, voffB);
        PG8_WAIT_V(6); PG8_BAR;
    }
    for (;;) {
        const bool has_next = S.next(ui + 1, nxt);
        const char* nA = has_next ? (const char*)g.A + (size_t)nxt.pm * tstep : cA; const char* nB = has_next ? (const char*)g.Bt + (size_t)nxt.pn * tstep : cB;
        for (int t = 0; t < nt; t += 2) {
            const bool last = (t == nt - 2);
            const char* a1 = cA + (size_t)(t + 1) * kstep;
            const char* a2 = last ? nA : cA + (size_t)(t + 2) * kstep; const char* b2 = last ? nB : cB + (size_t)(t + 2) * kstep;
            const char* a3 = a2 + kstep; const char* b3 = b2 + kstep;
            if (last && has_next) S.a_ready(nxt);
            if constexpr (SP2) {
            PG8_LDB(B0, 0, 0); PG8_LDB(B1, 0, 1); PG8_SCHED; PG8_LDA(At, 0, 0); PG8_STAGE(PG8_SA(1, 1), a1 + hstep, voffA);
            PG8_WAIT_V(8); PG8_WAIT_L(0); PG8_BAR; PG8_MMA(0, 0, At, B0); PG8_MMA(0, 1, At, B1); PG8_BAR; PG8_SCHED;
            PG8_LDA(At, 0, 1); PG8_STAGE(PG8_SB(0, 0), b2, voffB); PG8_STAGE(PG8_SB(0, 1), b2 + hstep, voffB); PG8_STAGE(PG8_SA(0, 0), a2, voffA);
            PG8_WAIT_V(8); PG8_WAIT_L(0); PG8_BAR; PG8_MMA(1, 0, At, B0); PG8_MMA(1, 1, At, B1); PG8_BAR; PG8_SCHED;
            PG8_LDB(B0, 1, 0); PG8_LDB(B1, 1, 1); PG8_SCHED; PG8_LDA(At, 1, 0); PG8_STAGE(PG8_SA(0, 1), a2 + hstep, voffA);
            PG8_WAIT_V(8); PG8_WAIT_L(0); PG8_BAR; PG8_MMA(0, 0, At, B0); PG8_MMA(0, 1, At, B1); PG8_BAR; PG8_SCHED;
            PG8_LDA(At, 1, 1); PG8_STAGE(PG8_SB(1, 0), b3, voffB); PG8_STAGE(PG8_SB(1, 1), b3 + hstep, voffB); PG8_STAGE(PG8_SA(1, 0), a3, voffA);
            PG8_WAIT_V(8); PG8_WAIT_L(0); PG8_BAR; PG8_MMA(1, 0, At, B0); PG8_MMA(1, 1, At, B1); PG8_BAR; PG8_SCHED;
            } else {
            PG8_LDB(B0, 0, 0); PG8_SCHED; PG8_LDA(At, 0, 0); PG8_STAGE(PG8_SA(1, 1), a1 + hstep, voffA);
            PG8_WAIT_L(8); PG8_BAR; PG8_WAIT_L(0); PG8_MMA(0, 0, At, B0); PG8_BAR; PG8_SCHED;
            PG8_LDB(B1, 0, 1); PG8_STAGE(PG8_SB(0, 0), b2, voffB);
            PG8_BAR; PG8_WAIT_L(0); PG8_MMA(0, 1, At, B1); PG8_BAR;
            PG8_LDA(At, 0, 1); PG8_STAGE(PG8_SA(0, 0), a2, voffA);
            PG8_BAR; PG8_WAIT_L(0); PG8_MMA(1, 0, At, B0); PG8_BAR; PG8_SCHED;
            PG8_STAGE(PG8_SB(0, 1), b2 + hstep, voffB);
            PG8_WAIT_V(6); PG8_BAR; PG8_MMA(1, 1, At, B1); PG8_BAR;
            PG8_LDB(B0, 1, 0); PG8_SCHED; PG8_LDA(At, 1, 0); PG8_STAGE(PG8_SA(0, 1), a2 + hstep, voffA);
            PG8_WAIT_L(8); PG8_BAR; PG8_WAIT_L(0); PG8_MMA(0, 0, At, B0); PG8_BAR; PG8_SCHED;
            PG8_LDB(B1, 1, 1); PG8_STAGE(PG8_SB(1, 0), b3, voffB);
            PG8_BAR; PG8_WAIT_L(0); PG8_MMA(0, 1, At, B1); PG8_BAR;
            PG8_LDA(At, 1, 1); PG8_STAGE(PG8_SA(1, 0), a3, voffA);
            PG8_BAR; PG8_WAIT_L(0); PG8_MMA(1, 0, At, B0); PG8_BAR; PG8_SCHED;
            PG8_STAGE(PG8_SB(1, 1), b3 + hstep, voffB);
            PG8_WAIT_V(6); PG8_BAR; PG8_MMA(1, 1, At, B1); PG8_BAR;
            }
        }
        if constexpr (ALIGN_EPI) { if (wr == 0) PG8_BAR; }
        if constexpr (!Epi::AFTER_DRAIN) { E(acc, cur, wr, wc, fr, fq); S.done(cur); }
        if (!has_next) break;
#pragma unroll
        for (int a = 0; a < 2; ++a)
#pragma unroll
            for (int b = 0; b < 2; ++b)
#pragma unroll
                for (int m = 0; m < 4; ++m)
#pragma unroll
                    for (int n = 0; n < 2; ++n) acc[a][b][m][n] = (f32x4){0.f, 0.f, 0.f, 0.f};
        cur = nxt; cA = nA; cB = nB; ++ui;
        if constexpr (ALIGN_EPI) { if (wr == 1) PG8_BAR; }
    }
    PG8_WAIT_V(0);
    if constexpr (!ALIGN_EPI) { if (wr == 0) PG8_BAR; }
    PG8_BAR;
    if constexpr (Epi::AFTER_DRAIN) { E.fused(acc, cur, wr, wc, fr, fq, lds, wid, lane); S.done(cur); }
#undef PG8_SA
#undef PG8_SB
#undef PG8_STAGE
#undef PG8_LDA
#undef PG8_LDB
#undef PG8_MMA
#undef PG8_WAIT_V
#undef PG8_WAIT_L
#undef PG8_BAR
#undef PG8_SCHED
}
}

#define LAS __attribute__((address_space(3)))
typedef unsigned short bf16;
typedef unsigned v4u __attribute__((ext_vector_type(4)));
typedef unsigned v2u __attribute__((ext_vector_type(2)));
typedef float f32x4 __attribute__((ext_vector_type(4)));
typedef short bf16x8 __attribute__((ext_vector_type(8)));

constexpr int D = 1024, NPR = 32768, NSR = 2048, M = NPR + NSR, NC = 2816, NSEQ = 36, NTILE = M / 64;
constexpr float EPS = 1e-6f;
constexpr size_t O_Y = 0, O_NAP = 35651584, O_NBP = O_NAP + 4096, O_NPP = O_NBP + 61440, O_MKP = O_NPP + 30720, O_MVP = O_MKP + 524288,
                 O_NAS = O_MVP + 524288, O_NBS = O_NAS + 32768, O_NPS = O_NBS + 491520, O_END = O_NPS + 245760;
constexpr size_t MiB = 1u << 20;
constexpr size_t WS_WIN = 0, WS_WOUT = 12 * MiB, WS_WMEM = 16 * MiB, WS_PWT = 18 * MiB, WS_RSM = 18 * MiB + 65536, WS_SSPA = 19 * MiB, WS_SSPB = 22 * MiB,
                 WS_CTL = 24 * MiB + 512 * 1024, WS_MNB = 25 * MiB, WS_KB = 28 * MiB, WS_VT = 38 * MiB, WS_XB = 48 * MiB, WS_Y = 116 * MiB, WS_U = 184 * MiB, WS_END = 372 * MiB;
constexpr int LDS_BYTES = 135168;

struct Params { const float* in[23]; float* out; unsigned char* ws; };

__device__ __forceinline__ unsigned cvtpk(float lo, float hi) { unsigned r; asm("v_cvt_pk_bf16_f32 %0, %1, %2" : "=v"(r) : "v"(lo), "v"(hi)); return r; }
__device__ __forceinline__ float bflo(unsigned u) { return __uint_as_float(u << 16); }
__device__ __forceinline__ float bfhi(unsigned u) { return __uint_as_float(u & 0xffff0000u); }
__device__ __forceinline__ float bf1(bf16 b) { return __uint_as_float(((unsigned)b) << 16); }
__device__ __forceinline__ float sigm(float x) { return __builtin_amdgcn_rcpf(1.f + __builtin_amdgcn_exp2f(-1.44269504f * x)); }
__device__ __forceinline__ float silu(float x) { return x * sigm(x); }
__device__ __forceinline__ void unpack8(v4u u, float (&f)[8]) { f[0] = bflo(u.x); f[1] = bfhi(u.x); f[2] = bflo(u.y); f[3] = bfhi(u.y); f[4] = bflo(u.z); f[5] = bfhi(u.z); f[6] = bflo(u.w); f[7] = bfhi(u.w); }
__device__ __forceinline__ v4u pack8(const float (&f)[8]) { v4u o; o.x = cvtpk(f[0], f[1]); o.y = cvtpk(f[2], f[3]); o.z = cvtpk(f[4], f[5]); o.w = cvtpk(f[6], f[7]); return o; }
__device__ __forceinline__ float wave_sum(float v) {
#pragma unroll
    for (int o = 1; o < 64; o <<= 1) v += __shfl_xor(v, o);
    return v;
}
#define LDS_WAIT() asm volatile("s_waitcnt lgkmcnt(0)" ::: "memory")

struct EpiU {
    static constexpr bool PERM = true, AFTER_DRAIN = false;
    bf16* U; const float* ssp;
    __device__ __forceinline__ void operator()(const f32x4 (&acc)[2][2][4][2], const pg8::Unit& u, int wr, int wc, int fr, int fq) const {
        const int row0 = u.pm * 256 + wr * 64 + fr, pn = u.pn, lc = wc * 32 + 8 * fq;
        float rs[2][4];
        {
            f32x4 sq[2][4];
#pragma unroll
            for (int ai = 0; ai < 2; ++ai)
#pragma unroll
                for (int m = 0; m < 4; ++m) sq[ai][m] = *(const f32x4*)(ssp + (size_t)(row0 + ai * 128 + m * 16) * 16 + fq * 4);
#pragma unroll
            for (int ai = 0; ai < 2; ++ai)
#pragma unroll
                for (int m = 0; m < 4; ++m) {
                    float t = (sq[ai][m].x + sq[ai][m].y) + (sq[ai][m].z + sq[ai][m].w);
                    t += __shfl_xor(t, 16); t += __shfl_xor(t, 32);
                    rs[ai][m] = rsqrtf(t * (1.0f / 1024.0f) + EPS);
                }
        }
#pragma unroll
        for (int ai = 0; ai < 2; ++ai)
#pragma unroll
            for (int m = 0; m < 4; ++m) {
                const int row = row0 + ai * 128 + m * 16;
                const float rstd = rs[ai][m];
                bf16* rowp = U + (size_t)row * 2048;
                if (pn < 6) {
                    const f32x4 a0 = acc[ai][0][m][0] * rstd, a1 = acc[ai][0][m][1] * rstd, g0 = acc[ai][1][m][0] * rstd, g1 = acc[ai][1][m][1] * rstd;
                    float o[8];
                    if ((pn >> 1) == 0) {
#pragma unroll
                        for (int j = 0; j < 4; ++j) { o[j] = a0[j] * silu(g0[j]); o[4 + j] = a1[j] * silu(g1[j]); }
                    } else if ((pn >> 1) == 1) {
#pragma unroll
                        for (int j = 0; j < 4; ++j) { o[j] = a0[j] * g0[j]; o[4 + j] = a1[j] * g1[j]; }
                    } else {
#pragma unroll
                        for (int j = 0; j < 4; ++j) { o[j] = a0[j] * sigm(g0[j]); o[4 + j] = a1[j] * sigm(g1[j]); }
                    }
                    *(v4u*)(rowp + (pn >> 1) * 256 + (pn & 1) * 128 + lc) = pack8(o);
                } else {
                    const float sc = (pn == 9) ? rstd * (0.125f * 1.44269504f) : rstd;
                    const bool act = (pn & 1) == 0;
#pragma unroll
                    for (int bj = 0; bj < 2; ++bj) {
                        const f32x4 v0 = acc[ai][bj][m][0] * sc, v1 = acc[ai][bj][m][1] * sc;
                        float o[8];
#pragma unroll
                        for (int j = 0; j < 4; ++j) { o[j] = act ? silu(v0[j]) : v0[j]; o[4 + j] = act ? silu(v1[j]) : v1[j]; }
                        *(v4u*)(rowp + 768 + (pn - 6) * 256 + bj * 128 + lc) = pack8(o);
                    }
                }
            }
    }
};
struct EpiX {
    static constexpr bool PERM = true, AFTER_DRAIN = false;
    bf16* XB; float* ssp; bf16* XO;
    __device__ __forceinline__ void operator()(const f32x4 (&acc)[2][2][4][2], const pg8::Unit& u, int wr, int wc, int fr, int fq) const {
        const int row0 = u.pm * 256 + wr * 64 + fr, col0 = u.pn * 256 + wc * 32 + 8 * fq;
#pragma unroll
        for (int ai = 0; ai < 2; ++ai) {
            v4u xv[4][2];
#pragma unroll
            for (int m = 0; m < 4; ++m)
#pragma unroll
                for (int bj = 0; bj < 2; ++bj) xv[m][bj] = *(const v4u*)(XB + (size_t)(row0 + ai * 128 + m * 16) * D + col0 + bj * 128);
#pragma unroll
            for (int m = 0; m < 4; ++m) {
                const int row = row0 + ai * 128 + m * 16;
                float ss = 0.f;
#pragma unroll
                for (int bj = 0; bj < 2; ++bj) {
                    float xo[8]; unpack8(xv[m][bj], xo);
                    const f32x4 a0 = acc[ai][bj][m][0], a1 = acc[ai][bj][m][1];
#pragma unroll
                    for (int j = 0; j < 4; ++j) { xo[j] += a0[j]; xo[4 + j] += a1[j]; }
#pragma unroll
                    for (int j = 0; j < 8; ++j) ss += xo[j] * xo[j];
                    *(v4u*)(XO + (size_t)row * D + col0 + bj * 128) = pack8(xo);
                }
                ss += __shfl_xor(ss, 16); ss += __shfl_xor(ss, 32);
                if (fq == 0) ssp[(size_t)row * 16 + u.pn * 4 + wc] = ss;
            }
        }
    }
};
struct EpiKV {
    static constexpr bool PERM = false, AFTER_DRAIN = true;
    const float* rsm; float* out; bf16* KB; bf16* VT;
    __device__ __forceinline__ void operator()(const f32x4 (&)[2][2][4][2], const pg8::Unit&, int, int, int, int) const {}
    __device__ __forceinline__ void fused(f32x4 (&acc)[2][2][4][2], const pg8::Unit& u, int wr, int wc, int fr, int fq, PG8_LAS unsigned char* lds, int wid, int lane) const {
        const int l = u.pn >> 1, isv = u.pn & 1, b = u.pm;
        const int mem0 = wr * 64 + fr, c0 = wc * 32 + 4 * fq;
        float* ob = out + O_MKP + (size_t)isv * (O_MVP - O_MKP) + (size_t)(l * 4 + b) * 65536;
        PG8_LAS bf16* img = (PG8_LAS bf16*)lds;
#pragma unroll
        for (int ai = 0; ai < 2; ++ai)
#pragma unroll
            for (int m = 0; m < 4; ++m) {
                const int mem = mem0 + ai * 128 + m * 16;
                const float rs = rsm[b * 256 + mem];
#pragma unroll
                for (int bj = 0; bj < 2; ++bj)
#pragma unroll
                    for (int n = 0; n < 2; ++n) {
                        const int c = c0 + bj * 128 + n * 16;
                        const f32x4 v = acc[ai][bj][m][n] * rs;
                        *(f32x4*)(ob + (size_t)mem * 256 + c) = v;
                        const int h = c >> 6, d = c & 63;
                        const unsigned w0 = cvtpk(v[0], v[1]), w1 = cvtpk(v[2], v[3]);
                        if (!isv) {
                            const int mt = (mem >> 5) * 2 + ((mem >> 2) & 1), r = ((mem >> 3) & 3) * 4 + (mem & 3), kk = d >> 5, q = (d >> 3) & 3, e = d & 7;
                            *(PG8_LAS v2u*)(img + ((h * 32 + mt * 2 + kk) * 512 + (q * 16 + r) * 8 + e)) = (v2u){w0, w1};
                        } else {
                            const int mp = mem >> 5, q = (mem >> 3) & 3, e = mem & 7, dt = d >> 4, r = d & 15;
                            PG8_LAS bf16* vp = img + ((h * 32 + mp * 4 + dt) * 512 + (q * 16 + r) * 8 + e);
                            vp[0] = (bf16)(w0 & 0xffffu); vp[8] = (bf16)(w0 >> 16); vp[16] = (bf16)(w1 & 0xffffu); vp[24] = (bf16)(w1 >> 16);
                        }
                    }
            }
        asm volatile("s_waitcnt lgkmcnt(0)" ::: "memory"); __builtin_amdgcn_s_barrier(); asm volatile("" ::: "memory");
        bf16* dst = KB + (ptrdiff_t)isv * (VT - KB) + (size_t)(l * NSEQ + b) * 65536;
        const int tid = wid * 64 + lane;
#pragma unroll
        for (int i = 0; i < 16; ++i) { const int ch = tid + 512 * i; *(v4u*)(dst + (size_t)ch * 8) = *(const PG8_LAS v4u*)(img + ch * 8); }
        asm volatile("s_waitcnt lgkmcnt(0)" ::: "memory"); __builtin_amdgcn_s_barrier(); asm volatile("" ::: "memory");
    }
};

__device__ __forceinline__ void transpose_item(const float* W, int K, int N, bf16* WT, int row_off, const float* gs, LAS float* scr, int item, int lane, bool remap = false) {
    const int nblk = N / 32, kb = item / nblk, nb = item % nblk, k0 = 64 * kb, n0 = 32 * nb;
    int d0 = n0;
    if (remap) { const int sp = n0 >> 8, ch = n0 & 255; if (sp < 6) { const int pair = (sp == 0 || sp == 3) ? 0 : ((sp == 1 || sp == 2) ? 1 : 2), bj = (sp == 3 || sp == 2 || sp == 5) ? 1 : 0; d0 = (pair * 2 + (ch >> 7)) * 256 + bj * 128 + (ch & 127); } }
    f32x4 tv[8];
#pragma unroll
    for (int i = 0; i < 8; ++i) { const int kk = 8 * i + (lane >> 3); tv[i] = *(const f32x4*)(W + (size_t)(k0 + kk) * N + n0 + (lane & 7) * 4); }
#pragma unroll
    for (int i = 0; i < 8; ++i) { const int kk = 8 * i + (lane >> 3); f32x4 v = tv[i]; if (gs) v = v * gs[k0 + kk];
        LAS float* d = scr + kk * 33 + (lane & 7) * 4; d[0] = v.x; d[1] = v.y; d[2] = v.z; d[3] = v.w; }
    LDS_WAIT();
    const int c = lane & 7;
#pragma unroll
    for (int j = 0; j < 4; ++j) { const int n = (lane >> 3) + 8 * j; const LAS float* s = scr + (8 * c) * 33 + n;
        v4u o; o.x = cvtpk(s[0 * 33], s[1 * 33]); o.y = cvtpk(s[2 * 33], s[3 * 33]); o.z = cvtpk(s[4 * 33], s[5 * 33]); o.w = cvtpk(s[6 * 33], s[7 * 33]);
        *(v4u*)(WT + (size_t)(row_off + d0 + n) * K + k0 + 8 * c) = o; }
    LDS_WAIT();
}
__device__ __forceinline__ float row_to_bf16(const float* xrow, bf16* orow, int lane) {
    const f32x4* xr = (const f32x4*)xrow + lane;
    f32x4 v[4]; float s = 0.f;
#pragma unroll
    for (int j = 0; j < 4; ++j) { v[j] = xr[64 * j]; s += (v[j].x * v[j].x + v[j].y * v[j].y) + (v[j].z * v[j].z + v[j].w * v[j].w); }
    s = wave_sum(s);
    v2u* o8 = (v2u*)orow + lane;
#pragma unroll
    for (int j = 0; j < 4; ++j) { v2u w; w.x = cvtpk(v[j].x, v[j].y); w.y = cvtpk(v[j].z, v[j].w); o8[64 * j] = w; }
    return s;
}

constexpr int UC = 2048, C_ABG = 0, C_V = 256, C_GLU = 512, C_SBG = 768, C_CU = 1024, C_SCG = 1280, C_Q = 1536, C_SXG = 1792;
struct Lay {
    const bf16* U; bf16* Y; const bf16* KB; const bf16* VT; const bf16* PWT;
    const float *caw, *cbw, *cbb, *lng, *lnb, *pbias, *pscale, *sta, *stb, *stp;
    float* out; int l;
};
struct Tile { int row0, seq, t0, first, last, samp, b; };
__device__ __forceinline__ Tile mk_tile(int tt) {
    Tile T; T.row0 = tt * 64;
    if (tt < 512) { T.seq = tt >> 7; T.t0 = (tt & 127) * 64; T.first = (tt & 127) == 0; T.last = (tt & 127) == 127; T.samp = 0; T.b = T.seq; }
    else { T.seq = 4 + (tt - 512); T.t0 = 0; T.first = 1; T.last = 1; T.samp = 1; T.b = tt - 512; }
    return T;
}
__device__ __forceinline__ void ld8f(const float* s, float (&f)[8]) { const f32x4 a = *(const f32x4*)s, b = *(const f32x4*)(s + 4); f[0] = a.x; f[1] = a.y; f[2] = a.z; f[3] = a.w; f[4] = b.x; f[5] = b.y; f[6] = b.z; f[7] = b.w; }

__device__ __forceinline__ void mix_a(const Lay& L, const Tile& T, int tid) {
    asm volatile("" : "+v"(tid));
    const int c0 = (tid & 31) * 8, tq = tid >> 5;
    const bf16* ub = L.U + (size_t)(T.row0 + tq * 4) * UC + c0;
    const bool hist = T.first && tq == 0;
    v4u rv[6], rb[4];
#pragma unroll
    for (int jj = 0; jj < 6; ++jj) rv[jj] = (jj >= 2 || !hist) ? __builtin_nontemporal_load((const v4u*)(ub + (jj - 2) * UC + C_V)) : (v4u){0u, 0u, 0u, 0u};
#pragma unroll
    for (int j = 0; j < 4; ++j) rb[j] = __builtin_nontemporal_load((const v4u*)(ub + j * UC + C_ABG));
    float w[3][8];
#pragma unroll
    for (int k = 0; k < 3; ++k) ld8f(L.caw + k * 256 + c0, w[k]);
    float v[6][8];
#pragma unroll
    for (int jj = 0; jj < 6; ++jj) unpack8(rv[jj], v[jj]);
    if (hist && T.samp) { ld8f(L.sta + ((size_t)T.b * 2 + 0) * 256 + c0, v[0]); ld8f(L.sta + ((size_t)T.b * 2 + 1) * 256 + c0, v[1]); }
#pragma unroll
    for (int j = 0; j < 4; ++j) {
        float fb[8], y[8]; unpack8(rb[j], fb);
#pragma unroll
        for (int i = 0; i < 8; ++i) y[i] = fb[i] * (w[0][i] * v[j][i] + w[1][i] * v[j + 1][i] + w[2][i] * v[j + 2][i]);
        *(v4u*)(L.Y + (size_t)(T.row0 + tq * 4 + j) * D + c0) = pack8(y);
    }
    if (T.last && tq == 15) {
#pragma unroll
        for (int j2 = 0; j2 < 2; ++j2) {
            float* dst = L.out + (T.samp ? O_NAS + ((size_t)(L.l * 32 + T.b) * 2 + j2) * 256 : O_NAP + ((size_t)(L.l * 4 + T.b) * 2 + j2) * 256) + c0;
            *(f32x4*)dst = (f32x4){v[4 + j2][0], v[4 + j2][1], v[4 + j2][2], v[4 + j2][3]};
            *(f32x4*)(dst + 4) = (f32x4){v[4 + j2][4], v[4 + j2][5], v[4 + j2][6], v[4 + j2][7]};
        }
    }
}

__device__ __forceinline__ void mix_b(const Lay& L, const Tile& T, int tid, LAS unsigned char* lds) {
    asm volatile("" : "+v"(tid));
    LAS float* G = (LAS float*)lds;
    LAS float* red = (LAS float*)(lds + 98304);
    LAS bf16* SB = (LAS bf16*)(lds + 100352);
    LAS float* stat = (LAS float*)(lds + 133632);
    const int c = tid & 255, th = tid >> 8, lane = tid & 63, wq = (tid >> 6) & 3;
    float w[31];
    {
        v4u rg[6], rs[4];
#pragma unroll
        for (int k = 0; k < 6; ++k) {
            const int i = tid + 512 * k, r = i >> 5, c0 = (i & 31) * 8, tt = r - 30;
            rg[k] = (i < 94 * 32 && (tt >= 0 || !T.first)) ? __builtin_nontemporal_load((const v4u*)(L.U + (size_t)(T.row0 + tt) * UC + C_GLU + c0)) : (v4u){0u, 0u, 0u, 0u};
        }
#pragma unroll
        for (int k = 0; k < 4; ++k) { const int i = tid + 512 * k, r = i >> 5, c0 = (i & 31) * 8; rs[k] = __builtin_nontemporal_load((const v4u*)(L.U + (size_t)(T.row0 + r) * UC + C_SBG + c0)); }
#pragma unroll
        for (int k = 0; k < 31; ++k) w[k] = L.cbw[k * 256 + c];
#pragma unroll
        for (int k = 0; k < 6; ++k) {
            const int i = tid + 512 * k, r = i >> 5, c0 = (i & 31) * 8, tt = r - 30;
            if (i < 94 * 32) {
                float g8[8]; unpack8(rg[k], g8);
                if (tt < 0 && T.first && T.samp) ld8f(L.stb + ((size_t)T.b * 30 + r) * 256 + c0, g8);
                *(LAS f32x4*)(G + r * 256 + c0) = (f32x4){g8[0], g8[1], g8[2], g8[3]};
                *(LAS f32x4*)(G + r * 256 + c0 + 4) = (f32x4){g8[4], g8[5], g8[6], g8[7]};
            }
        }
#pragma unroll
        for (int k = 0; k < 4; ++k) { const int i = tid + 512 * k; *(LAS v4u*)(SB + i * 8) = rs[k]; }
    }
    __syncthreads();
    const float bias = L.cbb[c];
    float z[4][8];
    {
        float g[62];
#pragma unroll
        for (int i = 0; i < 62; ++i) g[i] = G[(th * 32 + i) * 256 + c];
#pragma unroll
        for (int ch = 0; ch < 4; ++ch)
#pragma unroll
            for (int j = 0; j < 8; ++j) {
                float a = bias;
#pragma unroll
                for (int k = 0; k < 31; ++k) a += w[k] * g[ch * 8 + j + k];
                z[ch][j] = a;
            }
    }
    const bool b5 = (lane & 32) != 0, b4 = (lane & 16) != 0, b3 = (lane & 8) != 0;
#pragma unroll
    for (int ch = 0; ch < 4; ++ch) {
        const int tb = th * 32 + ch * 8;
        float r1[4], r2[4];
#pragma unroll
        for (int i = 0; i < 4; ++i) {
            const float za = z[ch][i], zb = z[ch][4 + i];
            const float k1 = b5 ? zb : za, s1 = b5 ? za : zb;
            r1[i] = k1 + __shfl_xor(s1, 32);
            const float k2 = b5 ? zb * zb : za * za, s2 = b5 ? za * za : zb * zb;
            r2[i] = k2 + __shfl_xor(s2, 32);
        }
        float q1[2], q2[2];
#pragma unroll
        for (int i = 0; i < 2; ++i) {
            const float k1 = b4 ? r1[2 + i] : r1[i], s1 = b4 ? r1[i] : r1[2 + i];
            q1[i] = k1 + __shfl_xor(s1, 16);
            const float k2 = b4 ? r2[2 + i] : r2[i], s2 = b4 ? r2[i] : r2[2 + i];
            q2[i] = k2 + __shfl_xor(s2, 16);
        }
        float d1 = (b3 ? q1[1] : q1[0]) + __shfl_xor(b3 ? q1[0] : q1[1], 8);
        float d2 = (b3 ? q2[1] : q2[0]) + __shfl_xor(b3 ? q2[0] : q2[1], 8);
        d1 += __shfl_xor(d1, 4); d1 += __shfl_xor(d1, 2); d1 += __shfl_xor(d1, 1);
        d2 += __shfl_xor(d2, 4); d2 += __shfl_xor(d2, 2); d2 += __shfl_xor(d2, 1);
        if ((lane & 7) == 0) { red[(tb + (lane >> 3)) * 8 + wq * 2] = d1; red[(tb + (lane >> 3)) * 8 + wq * 2 + 1] = d2; }
    }
    __syncthreads();
    if (T.last) {
        float* dst = L.out + (T.samp ? O_NBS + (size_t)(L.l * 32 + T.b) * 30 * 256 : O_NBP + (size_t)(L.l * 4 + T.b) * 30 * 256);
        for (int i = tid; i < 30 * 256; i += 512) dst[i] = G[64 * 256 + i];
    }
    if (tid < 64) {
        const f32x4 ra = *(LAS f32x4*)(red + tid * 8), rb = *(LAS f32x4*)(red + tid * 8 + 4);
        const float S1 = (ra.x + ra.z) + (rb.x + rb.z), S2 = (ra.y + ra.w) + (rb.y + rb.w);
        const float mu = S1 * (1.f / 256.f), var = S2 * (1.f / 256.f) - mu * mu;
        stat[tid * 2] = mu; stat[tid * 2 + 1] = rsqrtf(fmaxf(var, 0.f) + EPS);
    }
    const float lg = L.lng[c], lb = L.lnb[c];
    __syncthreads();
    {
        typedef float f32x2v __attribute__((ext_vector_type(2)));
        f32x2v st[4][8]; float gt[4][8];
#pragma unroll
        for (int ch = 0; ch < 4; ++ch)
#pragma unroll
            for (int j = 0; j < 8; ++j) { const int t = th * 32 + ch * 8 + j; st[ch][j] = *(const LAS f32x2v*)(stat + t * 2); gt[ch][j] = bf1(SB[t * 256 + c]); }
#pragma unroll
        for (int ch = 0; ch < 4; ++ch)
#pragma unroll
            for (int j = 0; j < 8; ++j) {
                const float zn = (z[ch][j] - st[ch][j].x) * (st[ch][j].y * lg) + lb;
                gt[ch][j] = silu(zn) * gt[ch][j];
            }
#pragma unroll
        for (int ch = 0; ch < 4; ++ch)
#pragma unroll
            for (int j = 0; j < 8; ++j) { const int t = th * 32 + ch * 8 + j; SB[t * 256 + c] = (bf16)(cvtpk(gt[ch][j], 0.f) & 0xffffu); }
    }
    __syncthreads();
#pragma unroll
    for (int k = 0; k < 4; ++k) { const int i = tid + 512 * k, r = i >> 5, c0 = (i & 31) * 8; *(v4u*)(L.Y + (size_t)(T.row0 + r) * D + 256 + c0) = *(LAS v4u*)(SB + i * 8); }
    __syncthreads();
}

__device__ __forceinline__ void mix_c(const Lay& L, const Tile& T, int tid, LAS unsigned char* lds) {
    asm volatile("" : "+v"(tid));
    LAS float* P = (LAS float*)lds;
    LAS bf16* Dm = (LAS bf16*)(lds + 81920);
    const int wave = tid >> 6, lane = tid & 63, mg = wave & 3, mth = wave >> 2, mr = lane & 15, mq = lane >> 4;
    v2u cg2[4][2];
    bf16x8 af[4][2];
    {
        v4u rg[5];
#pragma unroll
        for (int k = 0; k < 5; ++k) {
            const int i = tid + 512 * k, r = i >> 5, c0 = (i & 31) * 8, tt = r - 15;
            rg[k] = (i < 79 * 32 && (tt >= 0 || !T.first)) ? __builtin_nontemporal_load((const v4u*)(L.U + (size_t)(T.row0 + tt) * UC + C_CU + c0)) : (v4u){0u, 0u, 0u, 0u};
        }
#pragma unroll
        for (int mt = 0; mt < 4; ++mt)
#pragma unroll
            for (int nt = 0; nt < 2; ++nt) cg2[mt][nt] = *(const v2u*)(L.U + (size_t)(T.row0 + mth * 32 + nt * 16 + mr) * UC + C_SCG + mg * 64 + mt * 16 + 4 * mq);
#pragma unroll
        for (int mt = 0; mt < 4; ++mt)
#pragma unroll
            for (int kk = 0; kk < 2; ++kk) af[mt][kk] = *(const bf16x8*)(L.PWT + ((size_t)(mg * 64 + mt * 16 + mr)) * 64 + kk * 32 + mq * 8);
#pragma unroll
        for (int k = 0; k < 5; ++k) {
            const int i = tid + 512 * k, r = i >> 5, c0 = (i & 31) * 8, tt = r - 15;
            if (i < 79 * 32) {
                float g8[8]; unpack8(rg[k], g8);
                if (tt < 0 && T.first && T.samp) ld8f(L.stp + ((size_t)T.b * 15 + r) * 256 + c0, g8);
                *(LAS f32x4*)(P + r * 256 + c0) = (f32x4){g8[0], g8[1], g8[2], g8[3]};
                *(LAS f32x4*)(P + r * 256 + c0 + 4) = (f32x4){g8[4], g8[5], g8[6], g8[7]};
            }
        }
    }
    __syncthreads();
    {
        const int c = tid & 255, th = tid >> 8, g = __builtin_amdgcn_readfirstlane(c >> 6), w = 2 << g;
        const LAS float* Pc = P + th * 32 * 256 + c;
        float x[47], cur[32];
#pragma unroll
        for (int i = 0; i < 47; ++i) x[i] = Pc[i * 256];
#pragma unroll
        for (int i = 0; i < 32; ++i) cur[i] = x[15 + i];
#pragma unroll
        for (int i = 46; i >= 1; --i) x[i] += x[i - 1];
        if (g >= 1) {
#pragma unroll
            for (int i = 46; i >= 3; --i) x[i] += x[i - 2];
        }
        if (g >= 2) {
#pragma unroll
            for (int i = 46; i >= 7; --i) x[i] += x[i - 4];
        }
        if (g >= 3) {
#pragma unroll
            for (int i = 46; i >= 15; --i) x[i] += x[i - 8];
        }
        const int pos1 = (T.samp ? 1024 : 0) + T.t0 + th * 32 + 1;
        const float rw = __builtin_amdgcn_rcpf((float)w);
#pragma unroll
        for (int i = 0; i < 32; ++i) {
            const float rc = (pos1 + i >= w) ? rw : __builtin_amdgcn_rcpf((float)(pos1 + i));
            const float d = x[15 + i] * rc - cur[i];
            Dm[(th * 32 + i) * 264 + c] = (bf16)(cvtpk(d, 0.f) & 0xffffu);
        }
    }
    __syncthreads();
    if (T.last) {
        float* dst = L.out + (T.samp ? O_NPS + (size_t)(L.l * 32 + T.b) * 15 * 256 : O_NPP + (size_t)(L.l * 4 + T.b) * 15 * 256);
        for (int i = tid; i < 15 * 256; i += 512) dst[i] = P[64 * 256 + i];
    }
    {
        bf16x8 bfr[2][2];
#pragma unroll
        for (int nt = 0; nt < 2; ++nt)
#pragma unroll
            for (int kk = 0; kk < 2; ++kk) bfr[nt][kk] = *(const LAS bf16x8*)(Dm + (mth * 32 + nt * 16 + mr) * 264 + mg * 64 + kk * 32 + mq * 8);
        f32x4 acc[4][2];
#pragma unroll
        for (int mt = 0; mt < 4; ++mt)
#pragma unroll
            for (int nt = 0; nt < 2; ++nt) {
                f32x4 a = (f32x4){0.f, 0.f, 0.f, 0.f};
                a = __builtin_amdgcn_mfma_f32_16x16x32_bf16(af[mt][0], bfr[nt][0], a, 0, 0, 0);
                a = __builtin_amdgcn_mfma_f32_16x16x32_bf16(af[mt][1], bfr[nt][1], a, 0, 0, 0);
                acc[mt][nt] = a;
            }
#pragma unroll
        for (int mt = 0; mt < 4; ++mt) {
            const int chn = mg * 64 + mt * 16 + 4 * mq;
            const f32x4 pb = *(const f32x4*)(L.pbias + chn), ps = *(const f32x4*)(L.pscale + chn);
#pragma unroll
            for (int nt = 0; nt < 2; ++nt) {
                const size_t row = (size_t)(T.row0 + mth * 32 + nt * 16 + mr);
                const float y0 = (acc[mt][nt][0] + pb.x) * ps.x * bflo(cg2[mt][nt].x), y1 = (acc[mt][nt][1] + pb.y) * ps.y * bfhi(cg2[mt][nt].x);
                const float y2 = (acc[mt][nt][2] + pb.z) * ps.z * bflo(cg2[mt][nt].y), y3 = (acc[mt][nt][3] + pb.w) * ps.w * bfhi(cg2[mt][nt].y);
                v2u o; o.x = cvtpk(y0, y1); o.y = cvtpk(y2, y3);
                *(v2u*)(L.Y + row * D + 512 + chn) = o;
            }
        }
    }
    __syncthreads();
}

__device__ __forceinline__ void mix_x(const Lay& L, const Tile& T, int hp, int tid, LAS unsigned char* lds) {
    asm volatile("" : "+v"(tid));
    const int wave = __builtin_amdgcn_readfirstlane(tid >> 6), lane = tid & 63, hl = wave >> 2, h = hp * 2 + hl, nt = wave & 3, r = lane & 15, q = lane >> 4;
    const size_t row = (size_t)(T.row0 + nt * 16 + r);
    bf16x8 qf[2];
#pragma unroll
    for (int kk = 0; kk < 2; ++kk) qf[kk] = *(const bf16x8*)(L.U + row * UC + C_Q + h * 64 + kk * 32 + q * 8);
    v2u xg[4];
#pragma unroll
    for (int dt = 0; dt < 4; ++dt) xg[dt] = *(const v2u*)(L.U + row * UC + C_SXG + h * 64 + dt * 16 + 4 * q);
    {
        const char* ksrc = (const char*)(L.KB + ((size_t)T.seq * 4 + hp * 2) * 16384);
        const char* vsrc = (const char*)(L.VT + ((size_t)T.seq * 4 + hp * 2) * 16384);
#pragma unroll
        for (int i = 0; i < 8; ++i) {
            const int cb = i * 8 + wave;
            const int dst = (cb >> 5) * 65536 + (cb & 31) * 1024;
            __builtin_amdgcn_global_load_lds((const unsigned*)(ksrc + (size_t)cb * 1024 + lane * 16), (LAS unsigned*)(lds + dst), 16, 0, 0);
        }
#pragma unroll
        for (int i = 0; i < 8; ++i) {
            const int cb = i * 8 + wave;
            const int dst = (cb >> 5) * 65536 + (cb & 31) * 1024;
            __builtin_amdgcn_global_load_lds((const unsigned*)(vsrc + (size_t)cb * 1024 + lane * 16), (LAS unsigned*)(lds + dst + 32768), 16, 0, 0);
        }
    }
    asm volatile("s_waitcnt vmcnt(8)" ::: "memory");
    __builtin_amdgcn_s_barrier(); asm volatile("" ::: "memory");
    const LAS bf16x8* Kf = (const LAS bf16x8*)(lds + hl * 65536) + lane;
    const LAS bf16x8* Vf = (const LAS bf16x8*)(lds + hl * 65536 + 32768) + lane;
    f32x4 s[16];
#pragma unroll
    for (int mt = 0; mt < 16; ++mt) {
        const bf16x8 k0 = Kf[(mt * 2) * 64], k1 = Kf[(mt * 2 + 1) * 64];
        f32x4 a = (f32x4){0.f, 0.f, 0.f, 0.f};
        a = __builtin_amdgcn_mfma_f32_16x16x32_bf16(k0, qf[0], a, 0, 0, 0);
        a = __builtin_amdgcn_mfma_f32_16x16x32_bf16(k1, qf[1], a, 0, 0, 0);
        s[mt] = a;
    }
    float mx = -3.0e38f;
#pragma unroll
    for (int mt = 0; mt < 16; ++mt) mx = fmaxf(mx, fmaxf(fmaxf(s[mt][0], s[mt][1]), fmaxf(s[mt][2], s[mt][3])));
    mx = fmaxf(mx, __shfl_xor(mx, 16)); mx = fmaxf(mx, __shfl_xor(mx, 32));
    float sum = 0.f;
#pragma unroll
    for (int mt = 0; mt < 16; ++mt)
#pragma unroll
        for (int j = 0; j < 4; ++j) { const float pv = __builtin_amdgcn_exp2f(s[mt][j] - mx); s[mt][j] = pv; sum += pv; }
    sum += __shfl_xor(sum, 16); sum += __shfl_xor(sum, 32);
    const float inv = 1.0f / sum;
    f32x4 o[4];
#pragma unroll
    for (int dt = 0; dt < 4; ++dt) o[dt] = (f32x4){0.f, 0.f, 0.f, 0.f};
    asm volatile("s_waitcnt vmcnt(0)" ::: "memory");
    __builtin_amdgcn_s_barrier(); asm volatile("" ::: "memory");
#pragma unroll
    for (int mp = 0; mp < 8; ++mp) {
        v4u pk; pk.x = cvtpk(s[2 * mp][0], s[2 * mp][1]); pk.y = cvtpk(s[2 * mp][2], s[2 * mp][3]);
        pk.z = cvtpk(s[2 * mp + 1][0], s[2 * mp + 1][1]); pk.w = cvtpk(s[2 * mp + 1][2], s[2 * mp + 1][3]);
        const bf16x8 pf = __builtin_bit_cast(bf16x8, pk);
#pragma unroll
        for (int dt = 0; dt < 4; ++dt) o[dt] = __builtin_amdgcn_mfma_f32_16x16x32_bf16(Vf[(mp * 4 + dt) * 64], pf, o[dt], 0, 0, 0);
    }
#pragma unroll
    for (int dt = 0; dt < 4; ++dt) {
        const float y0 = o[dt][0] * inv * bflo(xg[dt].x), y1 = o[dt][1] * inv * bfhi(xg[dt].x);
        const float y2 = o[dt][2] * inv * bflo(xg[dt].y), y3 = o[dt][3] * inv * bfhi(xg[dt].y);
        v2u ov; ov.x = cvtpk(y0, y1); ov.y = cvtpk(y2, y3);
        *(v2u*)(L.Y + row * D + 768 + h * 64 + dt * 16 + 4 * q) = ov;
    }
    __syncthreads();
}

#define XB_TMO      128
#define XB_XCNT(j)  (256  + 64 * (j))
#define XB_XSUB(j)  (1280 + 64 * (j))
#define XB_XGEN(j)  (2304 + 64 * (j))
#define XB_TOP      3328
#define XB_TOPGEN   3392
#define XCD_BAR_WORDS 3456
#define XB_SPIN_CAP (1u << 18)

__device__ __forceinline__ unsigned xb_ld(unsigned* p)              { return __hip_atomic_load(p, __ATOMIC_RELAXED, __HIP_MEMORY_SCOPE_AGENT); }
__device__ __forceinline__ unsigned xb_add(unsigned* p, unsigned v) { return __hip_atomic_fetch_add(p, v, __ATOMIC_RELAXED, __HIP_MEMORY_SCOPE_AGENT); }
__device__ __forceinline__ unsigned xb_xcc_id() { return (unsigned)__builtin_amdgcn_s_getreg((3 << 11) | 20) & 0xFu; }
#define XB_SPIN(cond, bar) do { unsigned _sp = 0; while (cond) { __builtin_amdgcn_s_sleep(1); \
    if ((++_sp & 255u) == 0u) { if (xb_ld(&(bar)[XB_TMO])) break; if (_sp > XB_SPIN_CAP) { atomicAdd(&(bar)[XB_TMO], 1u); break; } } } } while (0)

struct XcdBarrier {
    unsigned* bar; unsigned x;
    volatile LAS unsigned* st;
};

__device__ __forceinline__ XcdBarrier xcd_barrier_post(unsigned* bar, volatile LAS unsigned* st) {
    XcdBarrier b; b.bar = bar; b.x = xb_xcc_id(); b.st = st;
    if (threadIdx.x == 0) (void)xb_add(&bar[XB_XCNT(b.x)], 1u);
    return b;
}
__device__ __forceinline__ void xcd_barrier_complete(unsigned* bar, unsigned x, unsigned& nloc, unsigned& nx) {
    const unsigned G = gridDim.x * gridDim.y * gridDim.z;
    unsigned sum, cnt, mine, sp = 0u;
    for (;;) {
        sum = 0u; cnt = 0u; mine = 0u;
#pragma unroll
        for (unsigned j = 0; j < 16; ++j) { const unsigned c = xb_ld(&bar[XB_XCNT(j)]); sum += c; cnt += (c > 0u) ? 1u : 0u; mine = (j == x) ? c : mine; }
        if (sum == G) break;
        __builtin_amdgcn_s_sleep(1);
        if ((++sp & 255u) == 0u) { if (xb_ld(&bar[XB_TMO])) break; if (sp > XB_SPIN_CAP) { atomicAdd(&bar[XB_TMO], 1u); break; } }
    }
    nloc = mine > 0u ? mine : 1u; nx = cnt > 0u ? cnt : 1u;
}

__device__ __forceinline__ void xcd_barrier(const XcdBarrier& b) {
    asm volatile("s_waitcnt vmcnt(0)" ::: "memory");
    __syncthreads();
    if (threadIdx.x == 0) {
        unsigned* bar = b.bar;
        __builtin_amdgcn_s_waitcnt(0);
        unsigned nloc = b.st[0], nx = b.st[1];
        if (nloc == 0u) { xcd_barrier_complete(bar, b.x, nloc, nx); b.st[0] = nloc; b.st[1] = nx; }
        const unsigned old = xb_add(&bar[XB_XSUB(b.x)], 1u);
        const unsigned gen = old / nloc;
        if (old + 1u == (gen + 1u) * nloc) {
            __builtin_amdgcn_fence(__ATOMIC_RELEASE, "agent");
            asm volatile("s_waitcnt vmcnt(0)" ::: "memory");
            const unsigned og = xb_add(&bar[XB_TOP], 1u);
            const unsigned tg = og / nx;
            if (og + 1u == (tg + 1u) * nx) xb_add(&bar[XB_TOPGEN], 1u);
            else XB_SPIN(xb_ld(&bar[XB_TOPGEN]) == tg, bar);
            __builtin_amdgcn_fence(__ATOMIC_ACQUIRE, "agent");
            xb_add(&bar[XB_XGEN(b.x)], 1u);
            asm volatile("s_waitcnt vmcnt(0)" ::: "memory");
        } else {
            XB_SPIN(xb_ld(&bar[XB_XGEN(b.x)]) == gen, bar);
            __builtin_amdgcn_fence(__ATOMIC_ACQUIRE, "agent");
            asm volatile("s_waitcnt vmcnt(0)" ::: "memory");
        }
    }
    __syncthreads();
}

#define WIN ((bf16*)(ws + WS_WIN))
#define WOUT ((bf16*)(ws + WS_WOUT))
#define WMEM ((bf16*)(ws + WS_WMEM))
#define W_PWT ((bf16*)(ws + WS_PWT))
#define RSM ((float*)(ws + WS_RSM))
#define SSPA ((float*)(ws + WS_SSPA))
#define SSPB ((float*)(ws + WS_SSPB))
#define MNB ((bf16*)(ws + WS_MNB))
#define W_KB ((bf16*)(ws + WS_KB))
#define W_VT ((bf16*)(ws + WS_VT))
#define XB ((bf16*)(ws + WS_XB))
#define YB ((bf16*)(ws + WS_Y))
#define UB ((bf16*)(ws + WS_U))
#define PHASE_WS __attribute__((address_space(1))) unsigned char* wsg_ = (__attribute__((address_space(1))) unsigned char*)p.ws; asm volatile("" : "+s"(wsg_)); unsigned char* ws = (unsigned char*)wsg_;
__global__ void __launch_bounds__(512, 2) hymba_fwd(Params p) {
    extern __shared__ __attribute__((aligned(16))) unsigned char lds_raw[];
    LAS unsigned char* lds = (LAS unsigned char*)lds_raw;
    cg::grid_group grid = cg::this_grid();
    const int tid = threadIdx.x, lane = tid & 63, wave = __builtin_amdgcn_readfirstlane(tid >> 6);
    const int G = gridDim.x, bx = blockIdx.x;
    if (tid < 2) ((LAS unsigned*)(lds + 133120))[tid] = 0u;
    __syncthreads();

    {
        PHASE_WS
        if (bx == 0) for (int i = tid; i < 4096; i += 512) ((unsigned*)(ws + WS_CTL))[i] = 0u;
        const float* xp = p.in[0]; const float* xs = p.in[1];
        LAS float* scr = (LAS float*)(lds + wave * 16384);
        const int gw = bx * 8 + wave, NGW = G * 8;
        constexpr int I_IN = 16 * 88, I_OUT = 16 * 32, I_MEM = 16 * 8, I_L = I_IN + I_OUT + 2 * I_MEM;
        for (int it = gw; it < 2 * I_L; it += NGW) {
            const int l = it / I_L; int r = it % I_L;
            if (r < I_IN) { transpose_item(p.in[9] + (size_t)l * D * NC, D, NC, WIN + (size_t)l * NC * D, 0, p.in[8] + l * D, scr, r, lane, true); continue; } r -= I_IN;
            if (r < I_OUT) { transpose_item(p.in[21] + (size_t)l * D * D, D, D, WOUT + (size_t)l * D * D, 0, nullptr, scr, r, lane); continue; } r -= I_OUT;
            if (r < I_MEM) { transpose_item(p.in[19] + (size_t)l * D * 256, D, 256, WMEM, l * 512, p.in[18] + l * D, scr, r, lane); continue; } r -= I_MEM;
            transpose_item(p.in[20] + (size_t)l * D * 256, D, 256, WMEM, l * 512 + 256, p.in[18] + l * D, scr, r, lane);
        }
        for (int m0 = gw; m0 < M; m0 += 4 * NGW) {
            f32x4 v[4][4]; float ss[4];
#pragma unroll
            for (int u = 0; u < 4; ++u) {
                const int m = m0 + u * NGW;
                const float* xr = m < NPR ? xp + (size_t)m * D : xs + (size_t)(m - NPR) * D;
#pragma unroll
                for (int j = 0; j < 4; ++j) v[u][j] = (m < M) ? __builtin_nontemporal_load((const f32x4*)xr + lane + 64 * j) : (f32x4){0.f, 0.f, 0.f, 0.f};
            }
#pragma unroll
            for (int u = 0; u < 4; ++u) {
                float a = 0.f;
#pragma unroll
                for (int j = 0; j < 4; ++j) a += (v[u][j].x * v[u][j].x + v[u][j].y * v[u][j].y) + (v[u][j].z * v[u][j].z + v[u][j].w * v[u][j].w);
                ss[u] = wave_sum(a);
            }
#pragma unroll
            for (int u = 0; u < 4; ++u) {
                const int m = m0 + u * NGW;
                if (m < M) {
                    v2u* o8 = (v2u*)(XB + (size_t)m * D) + lane;
#pragma unroll
                    for (int j = 0; j < 4; ++j) { v2u w; w.x = cvtpk(v[u][j].x, v[u][j].y); w.y = cvtpk(v[u][j].z, v[u][j].w); o8[64 * j] = w; }
                    if (lane < 16) SSPA[(size_t)m * 16 + lane] = (lane == 0) ? ss[u] : 0.f;
                }
            }
        }
        for (int m = gw; m < 1024; m += NGW) {
            const float ss = row_to_bf16(p.in[2] + (size_t)m * D, MNB + (size_t)m * D, lane);
            if (lane == 0) RSM[m] = rsqrtf(ss * (1.f / 1024.f) + EPS);
        }
        for (int i8 = bx * 512 + tid; i8 < 2 * 32 * 65536 / 8; i8 += G * 512) {
            const size_t i = (size_t)i8 * 8; const int l = (int)(i >> 21), b = (int)((i >> 16) & 31), mem = (int)((i >> 8) & 255), h = (int)((i >> 6) & 3), d = (int)(i & 63);
            const f32x4 a = *(const f32x4*)(p.in[6] + i), c = *(const f32x4*)(p.in[6] + i + 4);
            v4u o; o.x = cvtpk(a.x, a.y); o.y = cvtpk(a.z, a.w); o.z = cvtpk(c.x, c.y); o.w = cvtpk(c.z, c.w);
            const int mt = (mem >> 5) * 2 + ((mem >> 2) & 1), r = ((mem >> 3) & 3) * 4 + (mem & 3), kk = d >> 5, q = (d >> 3) & 3;
            *(v4u*)(W_KB + ((size_t)((l * NSEQ + 4 + b) * 4 + h) * 32 + mt * 2 + kk) * 512 + (q * 16 + r) * 8) = o;
        }
        for (int it = gw; it < 8192; it += NGW) {
            const int mg = it & 31, h = (it >> 5) & 3, b = (it >> 7) & 31, l = it >> 12;
            float f[8];
#pragma unroll
            for (int i = 0; i < 8; ++i) f[i] = p.in[7][(((size_t)(l * 32 + b) * 256 + mg * 8 + i) * 4 + h) * 64 + lane];
            const int mp = mg >> 2, q = mg & 3, dt = lane >> 4, r = lane & 15;
            *(v4u*)(W_VT + ((size_t)((l * NSEQ + 4 + b) * 4 + h) * 32 + mp * 4 + dt) * 512 + (q * 16 + r) * 8) = pack8(f);
        }
        for (int i = bx * 512 + tid; i < 32768; i += G * 512) {
            const int c = i & 63, e = (i >> 6) & 63, lg = i >> 12;
            W_PWT[i] = (bf16)(cvtpk(p.in[15][((size_t)lg * 64 + c) * 64 + e], 0.f) & 0xffffu);
        }
    }
    grid.sync();
    const XcdBarrier bar = xcd_barrier_post((unsigned*)(p.ws + WS_CTL), (volatile LAS unsigned*)(lds + 133120));

    {
        PHASE_WS
        pg8::Gemm g{MNB, WMEM, 1024, 1024, D}; pg8::StaticOrder S; S.init(1024, 1024, G, G - 1 - bx);
        EpiKV E{RSM, p.out, W_KB, W_VT};
        pg8::gemm_phase<EpiKV, pg8::StaticOrder, false, true>(lds, g, S, E);
    }

    for (int l = 0; l < 2; ++l) {
        {
            PHASE_WS
            pg8::Gemm g{XB, WIN + (size_t)l * NC * D, M, NC, D}; pg8::StaticOrder S; S.init(M, NC, G, bx);
            EpiU E{UB, l == 0 ? SSPA : SSPB};
            pg8::gemm_phase<EpiU, pg8::StaticOrder, true, true>(lds, g, S, E);
        }
        xcd_barrier(bar);
        {
            PHASE_WS
            Lay L;
            L.U = UB; L.Y = YB; L.KB = W_KB + (size_t)l * NSEQ * 65536; L.VT = W_VT + (size_t)l * NSEQ * 65536; L.PWT = W_PWT + (size_t)l * 16384;
            L.caw = p.in[10] + l * 768; L.cbw = p.in[11] + l * 31 * 256; L.cbb = p.in[12] + l * 256; L.lng = p.in[13] + l * 256; L.lnb = p.in[14] + l * 256;
            L.pbias = p.in[16] + l * 256; L.pscale = p.in[17] + l * 256;
            L.sta = p.in[3] + (size_t)l * 32 * 2 * 256; L.stb = p.in[4] + (size_t)l * 32 * 30 * 256; L.stp = p.in[5] + (size_t)l * 32 * 15 * 256;
            L.out = p.out; L.l = l;
            const int nk = (5 * NTILE - bx + G - 1) / G;
            for (int kk = 0; kk < nk; ++kk) {
                int k2 = kk + (bx >> 3) % nk; if (k2 >= nk) k2 -= nk;
                const int idx = bx + k2 * G;
                const int grp = idx / NTILE; const Tile T = mk_tile(idx % NTILE); const int hp = grp - 2;
                if (grp == 0) mix_b(L, T, tid, lds);
                else if (grp == 1) mix_c(L, T, tid, lds);
                else if (grp < 4) mix_x(L, T, hp, tid, lds);
                else mix_a(L, T, tid);
            }
        }
        xcd_barrier(bar);
        {
            PHASE_WS
            pg8::Gemm g{YB, WOUT + (size_t)l * D * D, M, D, D}; pg8::StaticOrder S; S.init(M, D, G, bx);
            EpiX E{XB, l == 0 ? SSPB : SSPA, XB};
            pg8::gemm_phase<EpiX, pg8::StaticOrder, true, true>(lds, g, S, E);
        }
        xcd_barrier(bar);
    }
    {
        PHASE_WS
        const int gw = bx * 8 + wave, NGW = G * 8;
        const float* gf = p.in[22];
        f32x4 gv[4];
#pragma unroll
        for (int j = 0; j < 4; ++j) gv[j] = ((const f32x4*)gf)[lane + 64 * j];
        for (int m = gw; m < M; m += NGW) {
            const f32x4* sp = (const f32x4*)(SSPA + (size_t)m * 16);
            const f32x4 s0 = sp[0], s1 = sp[1], s2 = sp[2], s3 = sp[3];
            const float ss = ((s0.x + s0.y) + (s0.z + s0.w)) + ((s1.x + s1.y) + (s1.z + s1.w)) + ((s2.x + s2.y) + (s2.z + s2.w)) + ((s3.x + s3.y) + (s3.z + s3.w));
            const float rstd = rsqrtf(ss * (1.f / 1024.f) + EPS);
            const v2u* xr = (const v2u*)(XB + (size_t)m * D) + lane;
            f32x4* yr = (f32x4*)(p.out + (size_t)m * D) + lane;
            v2u xv[4];
#pragma unroll
            for (int j = 0; j < 4; ++j) xv[j] = __builtin_nontemporal_load(xr + 64 * j);
#pragma unroll
            for (int j = 0; j < 4; ++j) { const f32x4 v = (f32x4){bflo(xv[j].x), bfhi(xv[j].x), bflo(xv[j].y), bfhi(xv[j].y)}; __builtin_nontemporal_store(v * rstd * gv[j], yr + 64 * j); }
        }
    }
}

extern "C" void kernel_launch(void* const* d_in, const int* in_sizes, int n_in, void* d_out, int out_size, void* d_ws, size_t ws_size, hipStream_t stream) {
    static int grid_blocks = 0;
    if (grid_blocks == 0) {
        if (n_in != 23 || (size_t)out_size != O_END || ws_size < WS_END) { fprintf(stderr, "kernel_launch: unexpected shapes (n_in %d out %d ws %zu)\n", n_in, out_size, ws_size); grid_blocks = -1; return; }
        int dev = 0, cus = 0, per_cu = 0;
        hipGetDevice(&dev);
        hipDeviceGetAttribute(&cus, hipDeviceAttributeMultiprocessorCount, dev);
        if (hipFuncSetAttribute((const void*)hymba_fwd, hipFuncAttributeMaxDynamicSharedMemorySize, LDS_BYTES) != hipSuccess) { fprintf(stderr, "kernel_launch: hipFuncSetAttribute failed\n"); grid_blocks = -1; return; }
        if (hipOccupancyMaxActiveBlocksPerMultiprocessor(&per_cu, (const void*)hymba_fwd, 512, LDS_BYTES) != hipSuccess || per_cu < 1) { fprintf(stderr, "kernel_launch: occupancy query says %d\n", per_cu); per_cu = 1; }
        (void)hipGetLastError();
        grid_blocks = cus * 1;
    }
    if (grid_blocks < 0) return;
    Params p{};
    for (int i = 0; i < 23; ++i) p.in[i] = (const float*)d_in[i];
    p.out = (float*)d_out; p.ws = (unsigned char*)d_ws;
    void* args[] = {&p};
    hipError_t e = hipLaunchCooperativeKernel((const void*)hymba_fwd, dim3(grid_blocks), dim3(512), args, LDS_BYTES, stream);
    if (e != hipSuccess) fprintf(stderr, "cooperative launch failed: %s (grid %d)\n", hipGetErrorString(e), grid_blocks);
}
```

```cpp
#include <hip/hip_runtime.h>
#include <hip/hip_cooperative_groups.h>
#include <cstdio>
#include <cstdint>
namespace cg = cooperative_groups;
namespace pg8 {
#define PG8_LAS __attribute__((address_space(3)))
typedef unsigned short bf16_t;
typedef short bf16x8 __attribute__((ext_vector_type(8)));
typedef float f32x4 __attribute__((ext_vector_type(4)));
typedef unsigned u32x4 __attribute__((ext_vector_type(4)));
constexpr int BM = 256, BK = 64, HALF = 128, HTB = HALF * BK * 2  , STAGE_BYTES = 8 * HTB, NXCD = 8, WGM = 8;

__host__ __device__ __forceinline__ int lds_byte(int r, int c) { const int st = (r >> 4) * 2 + (c >> 5), rr = r & 15, cc = c & 31, ob = rr * 64 + cc * 2; return st * 1024 + (ob ^ (((ob >> 9) & 1) << 5)); }
__host__ __device__ __forceinline__ void stage_rc(int b, int& R, int& C) { const int st = b / 1024, sb = b % 1024, swz = sb ^ (((sb >> 9) & 1) << 5); R = (st >> 1) * 16 + swz / 64; C = (st & 1) * 32 + (swz % 64) / 2; }
__host__ __device__ __forceinline__ int perm32(int rho) { const int n = rho >> 4, i = rho & 15; return 8 * (i >> 2) + 4 * n + (i & 3); }

struct Unit { int pm, pn; };
struct Gemm { const bf16_t* A; const bf16_t* Bt; int M, N, K; };

struct StaticOrder {
    int nM, nN, nwg, G, c;
    __host__ __device__ void init(int M, int N, int G_, int c_) { nM = M / BM; nN = N / BM; nwg = nM * nN; G = G_; c = c_; }
    __host__ __device__ bool next(int i, Unit& u) const {
        const long L = (long)i * G + c; if (L >= nwg) return false;
        int wgid = (int)L; { const int q = nwg / NXCD, r = nwg % NXCD, xcd = wgid % NXCD, off = wgid / NXCD; wgid = (xcd < r ? xcd * (q + 1) : r * (q + 1) + (xcd - r) * q) + off; }
        const int nig = WGM * nN, gid = wgid / nig, fm = gid * WGM, gsz = (nM - fm) < WGM ? (nM - fm) : WGM;
        u.pm = fm + ((wgid % nig) % gsz); u.pn = (wgid % nig) / gsz; return true;
    }
    __device__ __forceinline__ void a_ready(const Unit&) const {}
    __device__ __forceinline__ void done(const Unit&) const {}
};
__device__ __forceinline__ unsigned cvt_pk_bf16(float lo, float hi) { unsigned r; asm volatile("v_cvt_pk_bf16_f32 %0, %1, %2" : "=v"(r) : "v"(lo), "v"(hi)); return r; }
template <class Epi, class Sched, bool ALIGN_EPI = false, bool SP2 = false>
__device__ __forceinline__ void gemm_phase(PG8_LAS unsigned char* lds, const Gemm g, const Sched& S, const Epi& E) {
    const int tid = threadIdx.x, wid = __builtin_amdgcn_readfirstlane(tid >> 6), lane = tid & 63, wr = wid >> 2, wc = wid & 3, fr = lane & 15, fq = lane >> 4;
    const int K = g.K, nt = K / BK;
    unsigned voffA[2], voffB[2];
#pragma unroll
    for (int i = 0; i < 2; ++i) { int R, C; stage_rc(tid * 16 + i * 8192, R, C); const int Rb = Epi::PERM ? ((R & ~31) + perm32(R & 31)) : R;
        voffA[i] = (unsigned)(R * K + C) * 2u; voffB[i] = (unsigned)(Rb * K + C) * 2u; }
    const size_t kstep = (size_t)(BK * 2);
    const size_t hstep = (size_t)HALF * K * 2;
    const size_t tstep = 2 * hstep;
    const unsigned ldsw = (unsigned)wid * 1024u;
    const int aoff = lds_byte(wr * 64 + fr, fq * 8), boff = lds_byte(wc * 32 + fr, fq * 8);
#define PG8_SA(b, h) (((b) * 2 + (h)) * HTB)
#define PG8_SB(b, h) ((4 + (b) * 2 + (h)) * HTB)
#define PG8_STAGE(bufoff, gbase, voff) do { _Pragma("unroll") for (int _i = 0; _i < 2; ++_i) \
        __builtin_amdgcn_global_load_lds((const unsigned*)((const char*)(gbase) + (voff)[_i]), (PG8_LAS unsigned*)(lds + (bufoff) + ldsw + _i * 8192), 16, 0, 0); } while (0)
#define PG8_LDA(dst, b, h) do { _Pragma("unroll") for (int m = 0; m < 4; ++m) _Pragma("unroll") for (int k = 0; k < 2; ++k) dst[m][k] = *(const PG8_LAS bf16x8*)(lds + PG8_SA(b, h) + aoff + m * 2048 + k * 1024); } while (0)
#define PG8_LDB(dst, b, h) do { _Pragma("unroll") for (int n = 0; n < 2; ++n) _Pragma("unroll") for (int k = 0; k < 2; ++k) dst[n][k] = *(const PG8_LAS bf16x8*)(lds + PG8_SB(b, h) + boff + n * 2048 + k * 1024); } while (0)
#define PG8_MMA(ai, bj, At, Bt) do { __builtin_amdgcn_s_setprio(1); _Pragma("unroll") for (int m = 0; m < 4; ++m) _Pragma("unroll") for (int n = 0; n < 2; ++n) _Pragma("unroll") for (int k = 0; k < 2; ++k) \
        acc[ai][bj][m][n] = __builtin_amdgcn_mfma_f32_16x16x32_bf16(Bt[n][k], At[m][k], acc[ai][bj][m][n], 0, 0, 0); __builtin_amdgcn_s_setprio(0); } while (0)
#define PG8_WAIT_V(n) asm volatile("s_waitcnt vmcnt(" #n ")" ::: "memory")
#define PG8_WAIT_L(n) asm volatile("s_waitcnt lgkmcnt(" #n ")" ::: "memory")
#define PG8_BAR __builtin_amdgcn_s_barrier()
#define PG8_SCHED __builtin_amdgcn_sched_barrier(0)
    Unit cur, nxt; int ui = 0;
    if (!S.next(0, cur)) return;
    f32x4 acc[2][2][4][2];
#pragma unroll
    for (int a = 0; a < 2; ++a)
#pragma unroll
        for (int b = 0; b < 2; ++b)
#pragma unroll
            for (int m = 0; m < 4; ++m)
#pragma unroll
                for (int n = 0; n < 2; ++n) acc[a][b][m][n] = (f32x4){0.f, 0.f, 0.f, 0.f};
    bf16x8 At[4][2], B0[2][2], B1[2][2];
    const char* cA = (const char*)g.A + (size_t)cur.pm * tstep; const char* cB = (const char*)g.Bt + (size_t)cur.pn * tstep;
    S.a_ready(cur);
    if constexpr (SP2) {
        PG8_STAGE(PG8_SB(0, 0), cB, voffB); PG8_STAGE(PG8_SB(0, 1), cB + hstep, voffB); PG8_STAGE(PG8_SA(0, 0), cA, voffA); PG8_STAGE(PG8_SA(0, 1), cA + hstep, voffA);
        if (wr == 1) PG8_BAR;
        PG8_WAIT_V(2); PG8_BAR;
        PG8_STAGE(PG8_SB(1, 0), cB + kstep, voffB); PG8_STAGE(PG8_SA(1, 0), cA + kstep, voffA); PG8_STAGE(PG8_SB(1, 1), cB + hstep + kstep, voffB);
        PG8_WAIT_V(6); PG8_BAR;
    } else {
        PG8_STAGE(PG8_SB(0, 0), cB, voffB); PG8_STAGE(PG8_SA(0, 0), cA, voffA); PG8_STAGE(PG8_SB(0, 1), cB + hstep, voffB); PG8_STAGE(PG8_SA(0, 1), cA + hstep, voffA);
        if (wr == 1) PG8_BAR;
        PG8_WAIT_V(4); PG8_BAR;
        PG8_STAGE(PG8_SB(1, 0), cB + kstep, voffB); PG8_STAGE(PG8_SA(1, 0), cA + kstep, voffA); PG8_STAGE(PG8_SB(1, 1), cB + hstep + kstep, voffB);
        PG8_WAIT_V(6); PG8_BAR;
    }
    for (;;) {
        const bool has_next = S.next(ui + 1, nxt);
        const char* nA = has_next ? (const char*)g.A + (size_t)nxt.pm * tstep : cA; const char* nB = has_next ? (const char*)g.Bt + (size_t)nxt.pn * tstep : cB;
        for (int t = 0; t < nt; t += 2) {
            const bool last = (t == nt - 2);
            const char* a1 = cA + (size_t)(t + 1) * kstep;
            const char* a2 = last ? nA : cA + (size_t)(t + 2) * kstep; const char* b2 = last ? nB : cB + (size_t)(t + 2) * kstep;
            const char* a3 = a2 + kstep; const char* b3 = b2 + kstep;
            if (last && has_next) S.a_ready(nxt);
            if constexpr (SP2) {
            PG8_LDB(B0, 0, 0); PG8_LDB(B1, 0, 1); PG8_SCHED; PG8_LDA(At, 0, 0); PG8_STAGE(PG8_SA(1, 1), a1 + hstep, voffA);
            PG8_WAIT_V(8); PG8_WAIT_L(0); PG8_BAR; PG8_MMA(0, 0, At, B0); PG8_MMA(0, 1, At, B1); PG8_BAR; PG8_SCHED;
            PG8_LDA(At, 0, 1); PG8_STAGE(PG8_SB(0, 0), b2, voffB); PG8_STAGE(PG8_SB(0, 1), b2 + hstep, voffB); PG8_STAGE(PG8_SA(0, 0), a2, voffA);
            PG8_WAIT_V(8); PG8_WAIT_L(0); PG8_BAR; PG8_MMA(1, 0, At, B0); PG8_MMA(1, 1, At, B1); PG8_BAR; PG8_SCHED;
            PG8_LDB(B0, 1, 0); PG8_LDB(B1, 1, 1); PG8_SCHED; PG8_LDA(At, 1, 0); PG8_STAGE(PG8_SA(0, 1), a2 + hstep, voffA);
            PG8_WAIT_V(8); PG8_WAIT_L(0); PG8_BAR; PG8_MMA(0, 0, At, B0); PG8_MMA(0, 1, At, B1); PG8_BAR; PG8_SCHED;
            PG8_LDA(At, 1, 1); PG8_STAGE(PG8_SB(1, 0), b3, voffB); PG8_STAGE(PG8_SB(1, 1), b3 + hstep, voffB); PG8_STAGE(PG8_SA(1, 0), a3, voffA);
            PG8_WAIT_V(8); PG8_WAIT_L(0); PG8_BAR; PG8_MMA(1, 0, At, B0); PG8_MMA(1, 1, At, B1); PG8_BAR; PG8_SCHED;
            } else {
            PG8_LDB(B0, 0, 0); PG8_SCHED; PG8_LDA(At, 0, 0); PG8_STAGE(PG8_SA(1, 1), a1 + hstep, voffA);
            PG8_WAIT_L(8); PG8_BAR; PG8_WAIT_L(0); PG8_MMA(0, 0, At, B0); PG8_BAR; PG8_SCHED;
            PG8_LDB(B1, 0, 1); PG8_STAGE(PG8_SB(0, 0), b2, voffB);
            PG8_BAR; PG8_WAIT_L(0); PG8_MMA(0, 1, At, B1); PG8_BAR;
            PG8_LDA(At, 0, 1); PG8_STAGE(PG8_SA(0, 0), a2, voffA);
            PG8_BAR; PG8_WAIT_L(0); PG8_MMA(1, 0, At, B0); PG8_BAR; PG8_SCHED;
            PG8_STAGE(PG8_SB(0, 1), b2 + hstep, voffB);
            PG8_WAIT_V(6); PG8_BAR; PG8_MMA(1, 1, At, B1); PG8_BAR;
            PG8_LDB(B0, 1, 0); PG8_SCHED; PG8_LDA(At, 1, 0); PG8_STAGE(PG8_SA(0, 1), a2 + hstep, voffA);
            PG8_WAIT_L(8); PG8_BAR; PG8_WAIT_L(0); PG8_MMA(0, 0, At, B0); PG8_BAR; PG8_SCHED;
            PG8_LDB(B1, 1, 1); PG8_STAGE(PG8_SB(1, 0), b3, voffB);
            PG8_BAR; PG8_WAIT_L(0); PG8_MMA(0, 1, At, B1); PG8_BAR;
            PG8_LDA(At, 1, 1); PG8_STAGE(PG8_SA(1, 0), a3, voffA);
            PG8_BAR; PG8_WAIT_L(0); PG8_MMA(1, 0, At, B0); PG8_BAR; PG8_SCHED;
            PG8_STAGE(PG8_SB(1, 1), b3 + hstep, voffB);
            PG8_WAIT_V(6); PG8_BAR; PG8_MMA(1, 1, At, B1); PG8_BAR;
            }
        }
        if constexpr (ALIGN_EPI) { if (wr == 0) PG8_BAR; }
        if constexpr (!Epi::AFTER_DRAIN) { E(acc, cur, wr, wc, fr, fq); S.done(cur); }
        if (!has_next) break;
#pragma unroll
        for (int a = 0; a < 2; ++a)
#pragma unroll
            for (int b = 0; b < 2; ++b)
#pragma unroll
                for (int m = 0; m < 4; ++m)
#pragma unroll
                    for (int n = 0; n < 2; ++n) acc[a][b][m][n] = (f32x4){0.f, 0.f, 0.f, 0.f};
        cur = nxt; cA = nA; cB = nB; ++ui;
        if constexpr (ALIGN_EPI) { if (wr == 1) PG8_BAR; }
    }
    PG8_WAIT_V(0);
    if constexpr (!ALIGN_EPI) { if (wr == 0) PG8_BAR; }
    PG8_BAR;
    if constexpr (Epi::AFTER_DRAIN) { E.fused(acc, cur, wr, wc, fr, fq, lds, wid, lane); S.done(cur); }
#undef PG8_SA
#undef PG8_SB
#undef PG8_STAGE
#undef PG8_LDA
#undef PG8_LDB
#undef PG8_MMA
#undef PG8_WAIT_V
#undef PG8_WAIT_L
#undef PG8_BAR
#undef PG8_SCHED
}
}

#define LAS __attribute__((address_space(3)))
typedef unsigned short bf16;
typedef unsigned v4u __attribute__((ext_vector_type(4)));
typedef unsigned v2u __attribute__((ext_vector_type(2)));
typedef float f32x4 __attribute__((ext_vector_type(4)));
typedef short bf16x8 __attribute__((ext_vector_type(8)));

constexpr int D = 1024, NPR = 32768, NSR = 2048, M = NPR + NSR, NC = 2816, NSEQ = 36, NTILE = M / 64;
constexpr float EPS = 1e-6f;
constexpr size_t O_Y = 0, O_NAP = 35651584, O_NBP = O_NAP + 4096, O_NPP = O_NBP + 61440, O_MKP = O_NPP + 30720, O_MVP = O_MKP + 524288,
                 O_NAS = O_MVP + 524288, O_NBS = O_NAS + 32768, O_NPS = O_NBS + 491520, O_END = O_NPS + 245760;
constexpr size_t MiB = 1u << 20;
constexpr size_t WS_WIN = 0, WS_WOUT = 12 * MiB, WS_WMEM = 16 * MiB, WS_PWT = 18 * MiB, WS_RSM = 18 * MiB + 65536, WS_SSPA = 19 * MiB, WS_SSPB = 22 * MiB,
                 WS_CTL = 24 * MiB + 512 * 1024, WS_MNB = 25 * MiB, WS_KB = 28 * MiB, WS_VT = 38 * MiB, WS_XB = 48 * MiB, WS_Y = 116 * MiB, WS_U = 184 * MiB, WS_END = 372 * MiB;
constexpr int LDS_BYTES = 135168;

struct Params { const float* in[23]; float* out; unsigned char* ws; };

__device__ __forceinline__ unsigned cvtpk(float lo, float hi) { unsigned r; asm("v_cvt_pk_bf16_f32 %0, %1, %2" : "=v"(r) : "v"(lo), "v"(hi)); return r; }
__device__ __forceinline__ float bflo(unsigned u) { return __uint_as_float(u << 16); }
__device__ __forceinline__ float bfhi(unsigned u) { return __uint_as_float(u & 0xffff0000u); }
__device__ __forceinline__ float bf1(bf16 b) { return __uint_as_float(((unsigned)b) << 16); }
__device__ __forceinline__ float sigm(float x) { return __builtin_amdgcn_rcpf(1.f + __builtin_amdgcn_exp2f(-1.44269504f * x)); }
__device__ __forceinline__ float silu(float x) { return x * sigm(x); }
__device__ __forceinline__ void unpack8(v4u u, float (&f)[8]) { f[0] = bflo(u.x); f[1] = bfhi(u.x); f[2] = bflo(u.y); f[3] = bfhi(u.y); f[4] = bflo(u.z); f[5] = bfhi(u.z); f[6] = bflo(u.w); f[7] = bfhi(u.w); }
__device__ __forceinline__ v4u pack8(const float (&f)[8]) { v4u o; o.x = cvtpk(f[0], f[1]); o.y = cvtpk(f[2], f[3]); o.z = cvtpk(f[4], f[5]); o.w = cvtpk(f[6], f[7]); return o; }
__device__ __forceinline__ float wave_sum(float v) {
#pragma unroll
    for (int o = 1; o < 64; o <<= 1) v += __shfl_xor(v, o);
    return v;
}
#define LDS_WAIT() asm volatile("s_waitcnt lgkmcnt(0)" ::: "memory")
#define LBAR() do { asm volatile("s_waitcnt lgkmcnt(0)" ::: "memory"); __builtin_amdgcn_s_barrier(); asm volatile("" ::: "memory"); } while (0)

struct EpiU {
    static constexpr bool PERM = true, AFTER_DRAIN = false;
    bf16* U; const float* ssp;
    __device__ __forceinline__ void operator()(const f32x4 (&acc)[2][2][4][2], const pg8::Unit& u, int wr, int wc, int fr, int fq) const {
        const int row0 = u.pm * 256 + wr * 64 + fr, pn = u.pn, lc = wc * 32 + 8 * fq;
        float rs[2][4];
        {
            f32x4 sq[2][4];
#pragma unroll
            for (int ai = 0; ai < 2; ++ai)
#pragma unroll
                for (int m = 0; m < 4; ++m) sq[ai][m] = *(const f32x4*)(ssp + (size_t)(row0 + ai * 128 + m * 16) * 16 + fq * 4);
#pragma unroll
            for (int ai = 0; ai < 2; ++ai)
#pragma unroll
                for (int m = 0; m < 4; ++m) {
                    float t = (sq[ai][m].x + sq[ai][m].y) + (sq[ai][m].z + sq[ai][m].w);
                    t += __shfl_xor(t, 16); t += __shfl_xor(t, 32);
                    rs[ai][m] = rsqrtf(t * (1.0f / 1024.0f) + EPS);
                }
        }
#pragma unroll
        for (int ai = 0; ai < 2; ++ai)
#pragma unroll
            for (int m = 0; m < 4; ++m) {
                const int row = row0 + ai * 128 + m * 16;
                const float rstd = rs[ai][m];
                bf16* rowp = U + (size_t)row * 2048;
                if (pn < 6) {
                    const f32x4 a0 = acc[ai][0][m][0] * rstd, a1 = acc[ai][0][m][1] * rstd, g0 = acc[ai][1][m][0] * rstd, g1 = acc[ai][1][m][1] * rstd;
                    float o[8];
                    if ((pn >> 1) == 0) {
#pragma unroll
                        for (int j = 0; j < 4; ++j) { o[j] = a0[j] * silu(g0[j]); o[4 + j] = a1[j] * silu(g1[j]); }
                    } else if ((pn >> 1) == 1) {
#pragma unroll
                        for (int j = 0; j < 4; ++j) { o[j] = a0[j] * g0[j]; o[4 + j] = a1[j] * g1[j]; }
                    } else {
#pragma unroll
                        for (int j = 0; j < 4; ++j) { o[j] = a0[j] * sigm(g0[j]); o[4 + j] = a1[j] * sigm(g1[j]); }
                    }
                    *(v4u*)(rowp + (pn >> 1) * 256 + (pn & 1) * 128 + lc) = pack8(o);
                } else {
                    const float sc = (pn == 9) ? rstd * (0.125f * 1.44269504f) : rstd;
                    const bool act = (pn & 1) == 0;
#pragma unroll
                    for (int bj = 0; bj < 2; ++bj) {
                        const f32x4 v0 = acc[ai][bj][m][0] * sc, v1 = acc[ai][bj][m][1] * sc;
                        float o[8];
#pragma unroll
                        for (int j = 0; j < 4; ++j) { o[j] = act ? silu(v0[j]) : v0[j]; o[4 + j] = act ? silu(v1[j]) : v1[j]; }
                        *(v4u*)(rowp + 768 + (pn - 6) * 256 + bj * 128 + lc) = pack8(o);
                    }
                }
            }
    }
};
struct EpiX {
    static constexpr bool PERM = true, AFTER_DRAIN = false;
    bf16* XB; float* ssp; bf16* XO;
    __device__ __forceinline__ void operator()(const f32x4 (&acc)[2][2][4][2], const pg8::Unit& u, int wr, int wc, int fr, int fq) const {
        const int row0 = u.pm * 256 + wr * 64 + fr, col0 = u.pn * 256 + wc * 32 + 8 * fq;
#pragma unroll
        for (int ai = 0; ai < 2; ++ai) {
            v4u xv[4][2];
#pragma unroll
            for (int m = 0; m < 4; ++m)
#pragma unroll
                for (int bj = 0; bj < 2; ++bj) xv[m][bj] = *(const v4u*)(XB + (size_t)(row0 + ai * 128 + m * 16) * D + col0 + bj * 128);
#pragma unroll
            for (int m = 0; m < 4; ++m) {
                const int row = row0 + ai * 128 + m * 16;
                float ss = 0.f;
#pragma unroll
                for (int bj = 0; bj < 2; ++bj) {
                    float xo[8]; unpack8(xv[m][bj], xo);
                    const f32x4 a0 = acc[ai][bj][m][0], a1 = acc[ai][bj][m][1];
#pragma unroll
                    for (int j = 0; j < 4; ++j) { xo[j] += a0[j]; xo[4 + j] += a1[j]; }
#pragma unroll
                    for (int j = 0; j < 8; ++j) ss += xo[j] * xo[j];
                    *(v4u*)(XO + (size_t)row * D + col0 + bj * 128) = pack8(xo);
                }
                ss += __shfl_xor(ss, 16); ss += __shfl_xor(ss, 32);
                if (fq == 0) ssp[(size_t)row * 16 + u.pn * 4 + wc] = ss;
            }
        }
    }
};
struct EpiKV {
    static constexpr bool PERM = false, AFTER_DRAIN = true;
    const float* rsm; float* out; bf16* KB; bf16* VT;
    __device__ __forceinline__ void operator()(const f32x4 (&)[2][2][4][2], const pg8::Unit&, int, int, int, int) const {}
    __device__ __forceinline__ void fused(f32x4 (&acc)[2][2][4][2], const pg8::Unit& u, int wr, int wc, int fr, int fq, PG8_LAS unsigned char* lds, int wid, int lane) const {
        const int l = u.pn >> 1, isv = u.pn & 1, b = u.pm;
        const int mem0 = wr * 64 + fr, c0 = wc * 32 + 4 * fq;
        float* ob = out + O_MKP + (size_t)isv * (O_MVP - O_MKP) + (size_t)(l * 4 + b) * 65536;
        PG8_LAS bf16* img = (PG8_LAS bf16*)lds;
#pragma unroll
        for (int ai = 0; ai < 2; ++ai)
#pragma unroll
            for (int m = 0; m < 4; ++m) {
                const int mem = mem0 + ai * 128 + m * 16;
                const float rs = rsm[b * 256 + mem];
#pragma unroll
                for (int bj = 0; bj < 2; ++bj)
#pragma unroll
                    for (int n = 0; n < 2; ++n) {
                        const int c = c0 + bj * 128 + n * 16;
                        const f32x4 v = acc[ai][bj][m][n] * rs;
                        *(f32x4*)(ob + (size_t)mem * 256 + c) = v;
                        const int h = c >> 6, d = c & 63;
                        const unsigned w0 = cvtpk(v[0], v[1]), w1 = cvtpk(v[2], v[3]);
                        if (!isv) {
                            const int mt = (mem >> 5) * 2 + ((mem >> 2) & 1), r = ((mem >> 3) & 3) * 4 + (mem & 3), kk = d >> 5, q = (d >> 3) & 3, e = d & 7;
                            *(PG8_LAS v2u*)(img + ((h * 32 + mt * 2 + kk) * 512 + (q * 16 + r) * 8 + e)) = (v2u){w0, w1};
                        } else {
                            const int mp = mem >> 5, q = (mem >> 3) & 3, e = mem & 7, dt = d >> 4, r = d & 15;
                            PG8_LAS bf16* vp = img + ((h * 32 + mp * 4 + dt) * 512 + (q * 16 + r) * 8 + e);
                            vp[0] = (bf16)(w0 & 0xffffu); vp[8] = (bf16)(w0 >> 16); vp[16] = (bf16)(w1 & 0xffffu); vp[24] = (bf16)(w1 >> 16);
                        }
                    }
            }
        asm volatile("s_waitcnt lgkmcnt(0)" ::: "memory"); __builtin_amdgcn_s_barrier(); asm volatile("" ::: "memory");
        bf16* dst = KB + (ptrdiff_t)isv * (VT - KB) + (size_t)(l * NSEQ + b) * 65536;
        const int tid = wid * 64 + lane;
#pragma unroll
        for (int i = 0; i < 16; ++i) { const int ch = tid + 512 * i; *(v4u*)(dst + (size_t)ch * 8) = *(const PG8_LAS v4u*)(img + ch * 8); }
        asm volatile("s_waitcnt lgkmcnt(0)" ::: "memory"); __builtin_amdgcn_s_barrier(); asm volatile("" ::: "memory");
    }
};

__device__ __forceinline__ void transpose_item(const float* W, int K, int N, bf16* WT, int row_off, const float* gs, LAS float* scr, int item, int lane, bool remap = false) {
    const int nblk = N / 32, kb = item / nblk, nb = item % nblk, k0 = 64 * kb, n0 = 32 * nb;
    int d0 = n0;
    if (remap) { const int sp = n0 >> 8, ch = n0 & 255; if (sp < 6) { const int pair = (sp == 0 || sp == 3) ? 0 : ((sp == 1 || sp == 2) ? 1 : 2), bj = (sp == 3 || sp == 2 || sp == 5) ? 1 : 0; d0 = (pair * 2 + (ch >> 7)) * 256 + bj * 128 + (ch & 127); } }
    f32x4 tv[8];
#pragma unroll
    for (int i = 0; i < 8; ++i) { const int kk = 8 * i + (lane >> 3); tv[i] = *(const f32x4*)(W + (size_t)(k0 + kk) * N + n0 + (lane & 7) * 4); }
#pragma unroll
    for (int i = 0; i < 8; ++i) { const int kk = 8 * i + (lane >> 3); f32x4 v = tv[i]; if (gs) v = v * gs[k0 + kk];
        LAS float* d = scr + kk * 33 + (lane & 7) * 4; d[0] = v.x; d[1] = v.y; d[2] = v.z; d[3] = v.w; }
    LDS_WAIT();
    const int c = lane & 7;
#pragma unroll
    for (int j = 0; j < 4; ++j) { const int n = (lane >> 3) + 8 * j; const LAS float* s = scr + (8 * c) * 33 + n;
        v4u o; o.x = cvtpk(s[0 * 33], s[1 * 33]); o.y = cvtpk(s[2 * 33], s[3 * 33]); o.z = cvtpk(s[4 * 33], s[5 * 33]); o.w = cvtpk(s[6 * 33], s[7 * 33]);
        *(v4u*)(WT + (size_t)(row_off + d0 + n) * K + k0 + 8 * c) = o; }
    LDS_WAIT();
}
__device__ __forceinline__ float row_to_bf16(const float* xrow, bf16* orow, int lane) {
    const f32x4* xr = (const f32x4*)xrow + lane;
    f32x4 v[4]; float s = 0.f;
#pragma unroll
    for (int j = 0; j < 4; ++j) { v[j] = xr[64 * j]; s += (v[j].x * v[j].x + v[j].y * v[j].y) + (v[j].z * v[j].z + v[j].w * v[j].w); }
    s = wave_sum(s);
    v2u* o8 = (v2u*)orow + lane;
#pragma unroll
    for (int j = 0; j < 4; ++j) { v2u w; w.x = cvtpk(v[j].x, v[j].y); w.y = cvtpk(v[j].z, v[j].w); o8[64 * j] = w; }
    return s;
}

constexpr int UC = 2048, C_ABG = 0, C_V = 256, C_GLU = 512, C_SBG = 768, C_CU = 1024, C_SCG = 1280, C_Q = 1536, C_SXG = 1792;
struct Lay {
    const bf16* U; bf16* Y; const bf16* KB; const bf16* VT; const bf16* PWT;
    const float *caw, *cbw, *cbb, *lng, *lnb, *pbias, *pscale, *sta, *stb, *stp;
    float* out; int l;
};
struct Tile { int row0, seq, t0, first, last, samp, b; };
__device__ __forceinline__ Tile mk_tile(int tt) {
    Tile T; T.row0 = tt * 64;
    if (tt < 512) { T.seq = tt >> 7; T.t0 = (tt & 127) * 64; T.first = (tt & 127) == 0; T.last = (tt & 127) == 127; T.samp = 0; T.b = T.seq; }
    else { T.seq = 4 + (tt - 512); T.t0 = 0; T.first = 1; T.last = 1; T.samp = 1; T.b = tt - 512; }
    return T;
}
__device__ __forceinline__ void ld8f(const float* s, float (&f)[8]) { const f32x4 a = *(const f32x4*)s, b = *(const f32x4*)(s + 4); f[0] = a.x; f[1] = a.y; f[2] = a.z; f[3] = a.w; f[4] = b.x; f[5] = b.y; f[6] = b.z; f[7] = b.w; }

__device__ __forceinline__ void mix_a(const Lay& L, const Tile& T, int tid) {
    asm volatile("" : "+v"(tid));
    const int c0 = (tid & 31) * 8, tq = tid >> 5;
    const bf16* ub = L.U + (size_t)(T.row0 + tq * 4) * UC + c0;
    const bool hist = T.first && tq == 0;
    v4u rv[6], rb[4];
#pragma unroll
    for (int jj = 0; jj < 6; ++jj) rv[jj] = (jj >= 2 || !hist) ? __builtin_nontemporal_load((const v4u*)(ub + (jj - 2) * UC + C_V)) : (v4u){0u, 0u, 0u, 0u};
#pragma unroll
    for (int j = 0; j < 4; ++j) rb[j] = __builtin_nontemporal_load((const v4u*)(ub + j * UC + C_ABG));
    float w[3][8];
#pragma unroll
    for (int k = 0; k < 3; ++k) ld8f(L.caw + k * 256 + c0, w[k]);
    float v[6][8];
#pragma unroll
    for (int jj = 0; jj < 6; ++jj) unpack8(rv[jj], v[jj]);
    if (hist && T.samp) { ld8f(L.sta + ((size_t)T.b * 2 + 0) * 256 + c0, v[0]); ld8f(L.sta + ((size_t)T.b * 2 + 1) * 256 + c0, v[1]); }
#pragma unroll
    for (int j = 0; j < 4; ++j) {
        float fb[8], y[8]; unpack8(rb[j], fb);
#pragma unroll
        for (int i = 0; i < 8; ++i) y[i] = fb[i] * (w[0][i] * v[j][i] + w[1][i] * v[j + 1][i] + w[2][i] * v[j + 2][i]);
        *(v4u*)(L.Y + (size_t)(T.row0 + tq * 4 + j) * D + c0) = pack8(y);
    }
    if (T.last && tq == 15) {
#pragma unroll
        for (int j2 = 0; j2 < 2; ++j2) {
            float* dst = L.out + (T.samp ? O_NAS + ((size_t)(L.l * 32 + T.b) * 2 + j2) * 256 : O_NAP + ((size_t)(L.l * 4 + T.b) * 2 + j2) * 256) + c0;
            *(f32x4*)dst = (f32x4){v[4 + j2][0], v[4 + j2][1], v[4 + j2][2], v[4 + j2][3]};
            *(f32x4*)(dst + 4) = (f32x4){v[4 + j2][4], v[4 + j2][5], v[4 + j2][6], v[4 + j2][7]};
        }
    }
}

__device__ __forceinline__ void mix_b(const Lay& L, const Tile& T, int tid, LAS unsigned char* lds) {
    asm volatile("" : "+v"(tid));
    LAS float* G = (LAS float*)lds;
    LAS float* red = (LAS float*)(lds + 98304);
    LAS bf16* SB = (LAS bf16*)(lds + 100352);
    LAS float* stat = (LAS float*)(lds + 133632);
    const int c = tid & 255, th = tid >> 8, lane = tid & 63, wq = (tid >> 6) & 3;
    float w[31];
    {
        v4u rg[6], rs[4];
#pragma unroll
        for (int k = 0; k < 6; ++k) {
            const int i = tid + 512 * k, r = i >> 5, c0 = (i & 31) * 8, tt = r - 30;
            rg[k] = (i < 94 * 32 && (tt >= 0 || !T.first)) ? __builtin_nontemporal_load((const v4u*)(L.U + (size_t)(T.row0 + tt) * UC + C_GLU + c0)) : (v4u){0u, 0u, 0u, 0u};
        }
#pragma unroll
        for (int k = 0; k < 4; ++k) { const int i = tid + 512 * k, r = i >> 5, c0 = (i & 31) * 8; rs[k] = __builtin_nontemporal_load((const v4u*)(L.U + (size_t)(T.row0 + r) * UC + C_SBG + c0)); }
#pragma unroll
        for (int k = 0; k < 31; ++k) w[k] = L.cbw[k * 256 + c];
#pragma unroll
        for (int k = 0; k < 6; ++k) {
            const int i = tid + 512 * k, r = i >> 5, c0 = (i & 31) * 8, tt = r - 30;
            if (i < 94 * 32) {
                float g8[8]; unpack8(rg[k], g8);
                if (tt < 0 && T.first && T.samp) ld8f(L.stb + ((size_t)T.b * 30 + r) * 256 + c0, g8);
                *(LAS f32x4*)(G + r * 256 + c0) = (f32x4){g8[0], g8[1], g8[2], g8[3]};
                *(LAS f32x4*)(G + r * 256 + c0 + 4) = (f32x4){g8[4], g8[5], g8[6], g8[7]};
            }
        }
#pragma unroll
        for (int k = 0; k < 4; ++k) { const int i = tid + 512 * k; *(LAS v4u*)(SB + i * 8) = rs[k]; }
    }
    __syncthreads();
    const float bias = L.cbb[c];
    float z[4][8];
    {
        float g[62];
#pragma unroll
        for (int i = 0; i < 62; ++i) g[i] = G[(th * 32 + i) * 256 + c];
#pragma unroll
        for (int ch = 0; ch < 4; ++ch)
#pragma unroll
            for (int j = 0; j < 8; ++j) {
                float a = bias;
#pragma unroll
                for (int k = 0; k < 31; ++k) a += w[k] * g[ch * 8 + j + k];
                z[ch][j] = a;
            }
    }
    const bool b5 = (lane & 32) != 0, b4 = (lane & 16) != 0, b3 = (lane & 8) != 0;
#pragma unroll
    for (int ch = 0; ch < 4; ++ch) {
        const int tb = th * 32 + ch * 8;
        float r1[4], r2[4];
#pragma unroll
        for (int i = 0; i < 4; ++i) {
            const float za = z[ch][i], zb = z[ch][4 + i];
            const float k1 = b5 ? zb : za, s1 = b5 ? za : zb;
            r1[i] = k1 + __shfl_xor(s1, 32);
            const float k2 = b5 ? zb * zb : za * za, s2 = b5 ? za * za : zb * zb;
            r2[i] = k2 + __shfl_xor(s2, 32);
        }
        float q1[2], q2[2];
#pragma unroll
        for (int i = 0; i < 2; ++i) {
            const float k1 = b4 ? r1[2 + i] : r1[i], s1 = b4 ? r1[i] : r1[2 + i];
            q1[i] = k1 + __shfl_xor(s1, 16);
            const float k2 = b4 ? r2[2 + i] : r2[i], s2 = b4 ? r2[i] : r2[2 + i];
            q2[i] = k2 + __shfl_xor(s2, 16);
        }
        float d1 = (b3 ? q1[1] : q1[0]) + __shfl_xor(b3 ? q1[0] : q1[1], 8);
        float d2 = (b3 ? q2[1] : q2[0]) + __shfl_xor(b3 ? q2[0] : q2[1], 8);
        d1 += __shfl_xor(d1, 4); d1 += __shfl_xor(d1, 2); d1 += __shfl_xor(d1, 1);
        d2 += __shfl_xor(d2, 4); d2 += __shfl_xor(d2, 2); d2 += __shfl_xor(d2, 1);
        if ((lane & 7) == 0) { red[(tb + (lane >> 3)) * 8 + wq * 2] = d1; red[(tb + (lane >> 3)) * 8 + wq * 2 + 1] = d2; }
    }
    __syncthreads();
    if (T.last) {
        float* dst = L.out + (T.samp ? O_NBS + (size_t)(L.l * 32 + T.b) * 30 * 256 : O_NBP + (size_t)(L.l * 4 + T.b) * 30 * 256);
        for (int i = tid; i < 30 * 256; i += 512) dst[i] = G[64 * 256 + i];
    }
    if (tid < 64) {
        const f32x4 ra = *(LAS f32x4*)(red + tid * 8), rb = *(LAS f32x4*)(red + tid * 8 + 4);
        const float S1 = (ra.x + ra.z) + (rb.x + rb.z), S2 = (ra.y + ra.w) + (rb.y + rb.w);
        const float mu = S1 * (1.f / 256.f), var = S2 * (1.f / 256.f) - mu * mu;
        stat[tid * 2] = mu; stat[tid * 2 + 1] = rsqrtf(fmaxf(var, 0.f) + EPS);
    }
    const float lg = L.lng[c], lb = L.lnb[c];
    __syncthreads();
    {
        typedef float f32x2v __attribute__((ext_vector_type(2)));
        f32x2v st[4][8]; float gt[4][8];
#pragma unroll
        for (int ch = 0; ch < 4; ++ch)
#pragma unroll
            for (int j = 0; j < 8; ++j) { const int t = th * 32 + ch * 8 + j; st[ch][j] = *(const LAS f32x2v*)(stat + t * 2); gt[ch][j] = bf1(SB[t * 256 + c]); }
#pragma unroll
        for (int ch = 0; ch < 4; ++ch)
#pragma unroll
            for (int j = 0; j < 8; ++j) {
                const float zn = (z[ch][j] - st[ch][j].x) * (st[ch][j].y * lg) + lb;
                gt[ch][j] = silu(zn) * gt[ch][j];
            }
#pragma unroll
        for (int ch = 0; ch < 4; ++ch)
#pragma unroll
            for (int j = 0; j < 8; ++j) { const int t = th * 32 + ch * 8 + j; SB[t * 256 + c] = (bf16)(cvtpk(gt[ch][j], 0.f) & 0xffffu); }
    }
    __syncthreads();
#pragma unroll
    for (int k = 0; k < 4; ++k) { const int i = tid + 512 * k, r = i >> 5, c0 = (i & 31) * 8; *(v4u*)(L.Y + (size_t)(T.row0 + r) * D + 256 + c0) = *(LAS v4u*)(SB + i * 8); }
    LBAR();
}

__device__ __forceinline__ void mix_c(const Lay& L, const Tile& T, int tid, LAS unsigned char* lds) {
    asm volatile("" : "+v"(tid));
    LAS float* P = (LAS float*)lds;
    LAS bf16* Dm = (LAS bf16*)(lds + 81920);
    const int wave = tid >> 6, lane = tid & 63, mg = wave & 3, mth = wave >> 2, mr = lane & 15, mq = lane >> 4;
    v2u cg2[4][2];
    bf16x8 af[4][2];
    {
        v4u rg[5];
#pragma unroll
        for (int k = 0; k < 5; ++k) {
            const int i = tid + 512 * k, r = i >> 5, c0 = (i & 31) * 8, tt = r - 15;
            rg[k] = (i < 79 * 32 && (tt >= 0 || !T.first)) ? __builtin_nontemporal_load((const v4u*)(L.U + (size_t)(T.row0 + tt) * UC + C_CU + c0)) : (v4u){0u, 0u, 0u, 0u};
        }
#pragma unroll
        for (int mt = 0; mt < 4; ++mt)
#pragma unroll
            for (int nt = 0; nt < 2; ++nt) cg2[mt][nt] = *(const v2u*)(L.U + (size_t)(T.row0 + mth * 32 + nt * 16 + mr) * UC + C_SCG + mg * 64 + mt * 16 + 4 * mq);
#pragma unroll
        for (int mt = 0; mt < 4; ++mt)
#pragma unroll
            for (int kk = 0; kk < 2; ++kk) af[mt][kk] = *(const bf16x8*)(L.PWT + ((size_t)(mg * 64 + mt * 16 + mr)) * 64 + kk * 32 + mq * 8);
#pragma unroll
        for (int k = 0; k < 5; ++k) {
            const int i = tid + 512 * k, r = i >> 5, c0 = (i & 31) * 8, tt = r - 15;
            if (i < 79 * 32) {
                float g8[8]; unpack8(rg[k], g8);
                if (tt < 0 && T.first && T.samp) ld8f(L.stp + ((size_t)T.b * 15 + r) * 256 + c0, g8);
                *(LAS f32x4*)(P + r * 256 + c0) = (f32x4){g8[0], g8[1], g8[2], g8[3]};
                *(LAS f32x4*)(P + r * 256 + c0 + 4) = (f32x4){g8[4], g8[5], g8[6], g8[7]};
            }
        }
    }
    __syncthreads();
    {
        const int c = tid & 255, th = tid >> 8, g = __builtin_amdgcn_readfirstlane(c >> 6), w = 2 << g;
        const LAS float* Pc = P + th * 32 * 256 + c;
        float x[47], cur[32];
#pragma unroll
        for (int i = 0; i < 47; ++i) x[i] = Pc[i * 256];
#pragma unroll
        for (int i = 0; i < 32; ++i) cur[i] = x[15 + i];
#pragma unroll
        for (int i = 46; i >= 1; --i) x[i] += x[i - 1];
        if (g >= 1) {
#pragma unroll
            for (int i = 46; i >= 3; --i) x[i] += x[i - 2];
        }
        if (g >= 2) {
#pragma unroll
            for (int i = 46; i >= 7; --i) x[i] += x[i - 4];
        }
        if (g >= 3) {
#pragma unroll
            for (int i = 46; i >= 15; --i) x[i] += x[i - 8];
        }
        const int pos1 = (T.samp ? 1024 : 0) + T.t0 + th * 32 + 1;
        const float rw = __builtin_amdgcn_rcpf((float)w);
#pragma unroll
        for (int i = 0; i < 32; ++i) {
            const float rc = (pos1 + i >= w) ? rw : __builtin_amdgcn_rcpf((float)(pos1 + i));
            const float d = x[15 + i] * rc - cur[i];
            Dm[(th * 32 + i) * 264 + c] = (bf16)(cvtpk(d, 0.f) & 0xffffu);
        }
    }
    __syncthreads();
    if (T.last) {
        float* dst = L.out + (T.samp ? O_NPS + (size_t)(L.l * 32 + T.b) * 15 * 256 : O_NPP + (size_t)(L.l * 4 + T.b) * 15 * 256);
        for (int i = tid; i < 15 * 256; i += 512) dst[i] = P[64 * 256 + i];
    }
    {
        bf16x8 bfr[2][2];
#pragma unroll
        for (int nt = 0; nt < 2; ++nt)
#pragma unroll
            for (int kk = 0; kk < 2; ++kk) bfr[nt][kk] = *(const LAS bf16x8*)(Dm + (mth * 32 + nt * 16 + mr) * 264 + mg * 64 + kk * 32 + mq * 8);
        f32x4 acc[4][2];
#pragma unroll
        for (int mt = 0; mt < 4; ++mt)
#pragma unroll
            for (int nt = 0; nt < 2; ++nt) {
                f32x4 a = (f32x4){0.f, 0.f, 0.f, 0.f};
                a = __builtin_amdgcn_mfma_f32_16x16x32_bf16(af[mt][0], bfr[nt][0], a, 0, 0, 0);
                a = __builtin_amdgcn_mfma_f32_16x16x32_bf16(af[mt][1], bfr[nt][1], a, 0, 0, 0);
                acc[mt][nt] = a;
            }
#pragma unroll
        for (int mt = 0; mt < 4; ++mt) {
            const int chn = mg * 64 + mt * 16 + 4 * mq;
            const f32x4 pb = *(const f32x4*)(L.pbias + chn), ps = *(const f32x4*)(L.pscale + chn);
#pragma unroll
            for (int nt = 0; nt < 2; ++nt) {
                const size_t row = (size_t)(T.row0 + mth * 32 + nt * 16 + mr);
                const float y0 = (acc[mt][nt][0] + pb.x) * ps.x * bflo(cg2[mt][nt].x), y1 = (acc[mt][nt][1] + pb.y) * ps.y * bfhi(cg2[mt][nt].x);
                const float y2 = (acc[mt][nt][2] + pb.z) * ps.z * bflo(cg2[mt][nt].y), y3 = (acc[mt][nt][3] + pb.w) * ps.w * bfhi(cg2[mt][nt].y);
                v2u o; o.x = cvtpk(y0, y1); o.y = cvtpk(y2, y3);
                *(v2u*)(L.Y + row * D + 512 + chn) = o;
            }
        }
    }
    LBAR();
}

__device__ __forceinline__ void mix_x(const Lay& L, const Tile& T, int hp, int tid, LAS unsigned char* lds) {
    asm volatile("" : "+v"(tid));
    const int wave = __builtin_amdgcn_readfirstlane(tid >> 6), lane = tid & 63, hl = wave >> 2, h = hp * 2 + hl, nt = wave & 3, r = lane & 15, q = lane >> 4;
    const size_t row = (size_t)(T.row0 + nt * 16 + r);
    bf16x8 qf[2];
#pragma unroll
    for (int kk = 0; kk < 2; ++kk) qf[kk] = *(const bf16x8*)(L.U + row * UC + C_Q + h * 64 + kk * 32 + q * 8);
    v2u xg[4];
#pragma unroll
    for (int dt = 0; dt < 4; ++dt) xg[dt] = *(const v2u*)(L.U + row * UC + C_SXG + h * 64 + dt * 16 + 4 * q);
    {
        const char* ksrc = (const char*)(L.KB + ((size_t)T.seq * 4 + hp * 2) * 16384);
        const char* vsrc = (const char*)(L.VT + ((size_t)T.seq * 4 + hp * 2) * 16384);
#pragma unroll
        for (int i = 0; i < 8; ++i) {
            const int cb = i * 8 + wave;
            const int dst = (cb >> 5) * 65536 + (cb & 31) * 1024;
            __builtin_amdgcn_global_load_lds((const unsigned*)(ksrc + (size_t)cb * 1024 + lane * 16), (LAS unsigned*)(lds + dst), 16, 0, 0);
        }
#pragma unroll
        for (int i = 0; i < 8; ++i) {
            const int cb = i * 8 + wave;
            const int dst = (cb >> 5) * 65536 + (cb & 31) * 1024;
            __builtin_amdgcn_global_load_lds((const unsigned*)(vsrc + (size_t)cb * 1024 + lane * 16), (LAS unsigned*)(lds + dst + 32768), 16, 0, 0);
        }
    }
    asm volatile("s_waitcnt vmcnt(8)" ::: "memory");
    __builtin_amdgcn_s_barrier(); asm volatile("" ::: "memory");
    const LAS bf16x8* Kf = (const LAS bf16x8*)(lds + hl * 65536) + lane;
    const LAS bf16x8* Vf = (const LAS bf16x8*)(lds + hl * 65536 + 32768) + lane;
    f32x4 s[16];
#pragma unroll
    for (int mt = 0; mt < 16; ++mt) {
        const bf16x8 k0 = Kf[(mt * 2) * 64], k1 = Kf[(mt * 2 + 1) * 64];
        f32x4 a = (f32x4){0.f, 0.f, 0.f, 0.f};
        a = __builtin_amdgcn_mfma_f32_16x16x32_bf16(k0, qf[0], a, 0, 0, 0);
        a = __builtin_amdgcn_mfma_f32_16x16x32_bf16(k1, qf[1], a, 0, 0, 0);
        s[mt] = a;
    }
    float mx = -3.0e38f;
#pragma unroll
    for (int mt = 0; mt < 16; ++mt) mx = fmaxf(mx, fmaxf(fmaxf(s[mt][0], s[mt][1]), fmaxf(s[mt][2], s[mt][3])));
    mx = fmaxf(mx, __shfl_xor(mx, 16)); mx = fmaxf(mx, __shfl_xor(mx, 32));
    float sum = 0.f;
#pragma unroll
    for (int mt = 0; mt < 16; ++mt)
#pragma unroll
        for (int j = 0; j < 4; ++j) { const float pv = __builtin_amdgcn_exp2f(s[mt][j] - mx); s[mt][j] = pv; sum += pv; }
    sum += __shfl_xor(sum, 16); sum += __shfl_xor(sum, 32);
    const float inv = 1.0f / sum;
    f32x4 o[4];
#pragma unroll
    for (int dt = 0; dt < 4; ++dt) o[dt] = (f32x4){0.f, 0.f, 0.f, 0.f};
    asm volatile("s_waitcnt vmcnt(0)" ::: "memory");
    __builtin_amdgcn_s_barrier(); asm volatile("" ::: "memory");
#pragma unroll
    for (int mp = 0; mp < 8; ++mp) {
        v4u pk; pk.x = cvtpk(s[2 * mp][0], s[2 * mp][1]); pk.y = cvtpk(s[2 * mp][2], s[2 * mp][3]);
        pk.z = cvtpk(s[2 * mp + 1][0], s[2 * mp + 1][1]); pk.w = cvtpk(s[2 * mp + 1][2], s[2 * mp + 1][3]);
        const bf16x8 pf = __builtin_bit_cast(bf16x8, pk);
#pragma unroll
        for (int dt = 0; dt < 4; ++dt) o[dt] = __builtin_amdgcn_mfma_f32_16x16x32_bf16(Vf[(mp * 4 + dt) * 64], pf, o[dt], 0, 0, 0);
    }
#pragma unroll
    for (int dt = 0; dt < 4; ++dt) {
        const float y0 = o[dt][0] * inv * bflo(xg[dt].x), y1 = o[dt][1] * inv * bfhi(xg[dt].x);
        const float y2 = o[dt][2] * inv * bflo(xg[dt].y), y3 = o[dt][3] * inv * bfhi(xg[dt].y);
        v2u ov; ov.x = cvtpk(y0, y1); ov.y = cvtpk(y2, y3);
        *(v2u*)(L.Y + row * D + 768 + h * 64 + dt * 16 + 4 * q) = ov;
    }
    LBAR();
}

#define XB_TMO      128
#define XB_XCNT(j)  (256  + 64 * (j))
#define XB_XSUB(j)  (1280 + 64 * (j))
#define XB_XGEN(j)  (2304 + 64 * (j))
#define XB_TOP      3328
#define XB_TOPGEN   3392
#define XCD_BAR_WORDS 3456
#define XB_SPIN_CAP (1u << 18)

__device__ __forceinline__ unsigned xb_ld(unsigned* p)              { return __hip_atomic_load(p, __ATOMIC_RELAXED, __HIP_MEMORY_SCOPE_AGENT); }
__device__ __forceinline__ unsigned xb_add(unsigned* p, unsigned v) { return __hip_atomic_fetch_add(p, v, __ATOMIC_RELAXED, __HIP_MEMORY_SCOPE_AGENT); }
__device__ __forceinline__ unsigned xb_xcc_id() { return (unsigned)__builtin_amdgcn_s_getreg((3 << 11) | 20) & 0xFu; }
#define XB_SPIN(cond, bar) do { unsigned _sp = 0; while (cond) { __builtin_amdgcn_s_sleep(1); \
    if ((++_sp & 255u) == 0u) { if (xb_ld(&(bar)[XB_TMO])) break; if (_sp > XB_SPIN_CAP) { atomicAdd(&(bar)[XB_TMO], 1u); break; } } } } while (0)

struct XcdBarrier {
    unsigned* bar; unsigned x;
    volatile LAS unsigned* st;
};

__device__ __forceinline__ XcdBarrier xcd_barrier_post(unsigned* bar, volatile LAS unsigned* st) {
    XcdBarrier b; b.bar = bar; b.x = xb_xcc_id(); b.st = st;
    if (threadIdx.x == 0) (void)xb_add(&bar[XB_XCNT(b.x)], 1u);
    return b;
}
__device__ __forceinline__ void xcd_barrier_complete(unsigned* bar, unsigned x, unsigned& nloc, unsigned& nx) {
    const unsigned G = gridDim.x * gridDim.y * gridDim.z;
    unsigned sum, cnt, mine, sp = 0u;
    for (;;) {
        sum = 0u; cnt = 0u; mine = 0u;
#pragma unroll
        for (unsigned j = 0; j < 16; ++j) { const unsigned c = xb_ld(&bar[XB_XCNT(j)]); sum += c; cnt += (c > 0u) ? 1u : 0u; mine = (j == x) ? c : mine; }
        if (sum == G) break;
        __builtin_amdgcn_s_sleep(1);
        if ((++sp & 255u) == 0u) { if (xb_ld(&bar[XB_TMO])) break; if (sp > XB_SPIN_CAP) { atomicAdd(&bar[XB_TMO], 1u); break; } }
    }
    nloc = mine > 0u ? mine : 1u; nx = cnt > 0u ? cnt : 1u;
}

__device__ __forceinline__ void xcd_barrier(const XcdBarrier& b) {
    asm volatile("s_waitcnt vmcnt(0)" ::: "memory");
    __syncthreads();
    if (threadIdx.x == 0) {
        unsigned* bar = b.bar;
        __builtin_amdgcn_s_waitcnt(0);
        unsigned nloc = b.st[0], nx = b.st[1];
        if (nloc == 0u) { xcd_barrier_complete(bar, b.x, nloc, nx); b.st[0] = nloc; b.st[1] = nx; }
        const unsigned old = xb_add(&bar[XB_XSUB(b.x)], 1u);
        const unsigned gen = old / nloc;
        if (old + 1u == (gen + 1u) * nloc) {
            __builtin_amdgcn_fence(__ATOMIC_RELEASE, "agent");
            asm volatile("s_waitcnt vmcnt(0)" ::: "memory");
            const unsigned og = xb_add(&bar[XB_TOP], 1u);
            const unsigned tg = og / nx;
            if (og + 1u == (tg + 1u) * nx) xb_add(&bar[XB_TOPGEN], 1u);
            else XB_SPIN(xb_ld(&bar[XB_TOPGEN]) == tg, bar);
            __builtin_amdgcn_fence(__ATOMIC_ACQUIRE, "agent");
            xb_add(&bar[XB_XGEN(b.x)], 1u);
            asm volatile("s_waitcnt vmcnt(0)" ::: "memory");
        } else {
            XB_SPIN(xb_ld(&bar[XB_XGEN(b.x)]) == gen, bar);
            __builtin_amdgcn_fence(__ATOMIC_ACQUIRE, "agent");
            asm volatile("s_waitcnt vmcnt(0)" ::: "memory");
        }
    }
    __syncthreads();
}

#define WIN ((bf16*)(ws + WS_WIN))
#define WOUT ((bf16*)(ws + WS_WOUT))
#define WMEM ((bf16*)(ws + WS_WMEM))
#define W_PWT ((bf16*)(ws + WS_PWT))
#define RSM ((float*)(ws + WS_RSM))
#define SSPA ((float*)(ws + WS_SSPA))
#define SSPB ((float*)(ws + WS_SSPB))
#define MNB ((bf16*)(ws + WS_MNB))
#define W_KB ((bf16*)(ws + WS_KB))
#define W_VT ((bf16*)(ws + WS_VT))
#define XB ((bf16*)(ws + WS_XB))
#define YB ((bf16*)(ws + WS_Y))
#define UB ((bf16*)(ws + WS_U))
#define PHASE_WS __attribute__((address_space(1))) unsigned char* wsg_ = (__attribute__((address_space(1))) unsigned char*)p.ws; asm volatile("" : "+s"(wsg_)); unsigned char* ws = (unsigned char*)wsg_;
__global__ void __launch_bounds__(512, 2) hymba_fwd(Params p) {
    extern __shared__ __attribute__((aligned(16))) unsigned char lds_raw[];
    LAS unsigned char* lds = (LAS unsigned char*)lds_raw;
    cg::grid_group grid = cg::this_grid();
    const int tid = threadIdx.x, lane = tid & 63, wave = __builtin_amdgcn_readfirstlane(tid >> 6);
    const int G = gridDim.x, bx = blockIdx.x;
    if (tid < 2) ((LAS unsigned*)(lds + 133120))[tid] = 0u;
    __syncthreads();

    {
        PHASE_WS
        if (bx == 0) for (int i = tid; i < 4096; i += 512) ((unsigned*)(ws + WS_CTL))[i] = 0u;
        const float* xp = p.in[0]; const float* xs = p.in[1];
        LAS float* scr = (LAS float*)(lds + wave * 16384);
        const int gw = bx * 8 + wave, NGW = G * 8;
        constexpr int I_IN = 16 * 88, I_OUT = 16 * 32, I_MEM = 16 * 8, I_L = I_IN + I_OUT + 2 * I_MEM;
        for (int it = gw; it < 2 * I_L; it += NGW) {
            const int l = it / I_L; int r = it % I_L;
            if (r < I_IN) { transpose_item(p.in[9] + (size_t)l * D * NC, D, NC, WIN + (size_t)l * NC * D, 0, p.in[8] + l * D, scr, r, lane, true); continue; } r -= I_IN;
            if (r < I_OUT) { transpose_item(p.in[21] + (size_t)l * D * D, D, D, WOUT + (size_t)l * D * D, 0, nullptr, scr, r, lane); continue; } r -= I_OUT;
            if (r < I_MEM) { transpose_item(p.in[19] + (size_t)l * D * 256, D, 256, WMEM, l * 512, p.in[18] + l * D, scr, r, lane); continue; } r -= I_MEM;
            transpose_item(p.in[20] + (size_t)l * D * 256, D, 256, WMEM, l * 512 + 256, p.in[18] + l * D, scr, r, lane);
        }
        for (int m0 = gw; m0 < M; m0 += 4 * NGW) {
            f32x4 v[4][4]; float ss[4];
#pragma unroll
            for (int u = 0; u < 4; ++u) {
                const int m = m0 + u * NGW;
                const float* xr = m < NPR ? xp + (size_t)m * D : xs + (size_t)(m - NPR) * D;
#pragma unroll
                for (int j = 0; j < 4; ++j) v[u][j] = (m < M) ? __builtin_nontemporal_load((const f32x4*)xr + lane + 64 * j) : (f32x4){0.f, 0.f, 0.f, 0.f};
            }
#pragma unroll
            for (int u = 0; u < 4; ++u) {
                float a = 0.f;
#pragma unroll
                for (int j = 0; j < 4; ++j) a += (v[u][j].x * v[u][j].x + v[u][j].y * v[u][j].y) + (v[u][j].z * v[u][j].z + v[u][j].w * v[u][j].w);
                ss[u] = wave_sum(a);
            }
#pragma unroll
            for (int u = 0; u < 4; ++u) {
                const int m = m0 + u * NGW;
                if (m < M) {
                    v2u* o8 = (v2u*)(XB + (size_t)m * D) + lane;
#pragma unroll
                    for (int j = 0; j < 4; ++j) { v2u w; w.x = cvtpk(v[u][j].x, v[u][j].y); w.y = cvtpk(v[u][j].z, v[u][j].w); o8[64 * j] = w; }
                    if (lane < 16) SSPA[(size_t)m * 16 + lane] = (lane == 0) ? ss[u] : 0.f;
                }
            }
        }
        for (int m = gw; m < 1024; m += NGW) {
            const float ss = row_to_bf16(p.in[2] + (size_t)m * D, MNB + (size_t)m * D, lane);
            if (lane == 0) RSM[m] = rsqrtf(ss * (1.f / 1024.f) + EPS);
        }
        for (int i8 = bx * 512 + tid; i8 < 2 * 32 * 65536 / 8; i8 += G * 512) {
            const size_t i = (size_t)i8 * 8; const int l = (int)(i >> 21), b = (int)((i >> 16) & 31), mem = (int)((i >> 8) & 255), h = (int)((i >> 6) & 3), d = (int)(i & 63);
            const f32x4 a = *(const f32x4*)(p.in[6] + i), c = *(const f32x4*)(p.in[6] + i + 4);
            v4u o; o.x = cvtpk(a.x, a.y); o.y = cvtpk(a.z, a.w); o.z = cvtpk(c.x, c.y); o.w = cvtpk(c.z, c.w);
            const int mt = (mem >> 5) * 2 + ((mem >> 2) & 1), r = ((mem >> 3) & 3) * 4 + (mem & 3), kk = d >> 5, q = (d >> 3) & 3;
            *(v4u*)(W_KB + ((size_t)((l * NSEQ + 4 + b) * 4 + h) * 32 + mt * 2 + kk) * 512 + (q * 16 + r) * 8) = o;
        }
        for (int it = gw; it < 8192; it += NGW) {
            const int mg = it & 31, h = (it >> 5) & 3, b = (it >> 7) & 31, l = it >> 12;
            float f[8];
#pragma unroll
            for (int i = 0; i < 8; ++i) f[i] = p.in[7][(((size_t)(l * 32 + b) * 256 + mg * 8 + i) * 4 + h) * 64 + lane];
            const int mp = mg >> 2, q = mg & 3, dt = lane >> 4, r = lane & 15;
            *(v4u*)(W_VT + ((size_t)((l * NSEQ + 4 + b) * 4 + h) * 32 + mp * 4 + dt) * 512 + (q * 16 + r) * 8) = pack8(f);
        }
        for (int i = bx * 512 + tid; i < 32768; i += G * 512) {
            const int c = i & 63, e = (i >> 6) & 63, lg = i >> 12;
            W_PWT[i] = (bf16)(cvtpk(p.in[15][((size_t)lg * 64 + c) * 64 + e], 0.f) & 0xffffu);
        }
    }
    grid.sync();
    const XcdBarrier bar = xcd_barrier_post((unsigned*)(p.ws + WS_CTL), (volatile LAS unsigned*)(lds + 133120));

    {
        PHASE_WS
        pg8::Gemm g{MNB, WMEM, 1024, 1024, D}; pg8::StaticOrder S; S.init(1024, 1024, G, G - 1 - bx);
        EpiKV E{RSM, p.out, W_KB, W_VT};
        pg8::gemm_phase<EpiKV, pg8::StaticOrder, false, true>(lds, g, S, E);
    }

    for (int l = 0; l < 2; ++l) {
        {
            PHASE_WS
            pg8::Gemm g{XB, WIN + (size_t)l * NC * D, M, NC, D}; pg8::StaticOrder S; S.init(M, NC, G, bx);
            EpiU E{UB, l == 0 ? SSPA : SSPB};
            pg8::gemm_phase<EpiU, pg8::StaticOrder, true, true>(lds, g, S, E);
        }
        xcd_barrier(bar);
        {
            PHASE_WS
            Lay L;
            L.U = UB; L.Y = YB; L.KB = W_KB + (size_t)l * NSEQ * 65536; L.VT = W_VT + (size_t)l * NSEQ * 65536; L.PWT = W_PWT + (size_t)l * 16384;
            L.caw = p.in[10] + l * 768; L.cbw = p.in[11] + l * 31 * 256; L.cbb = p.in[12] + l * 256; L.lng = p.in[13] + l * 256; L.lnb = p.in[14] + l * 256;
            L.pbias = p.in[16] + l * 256; L.pscale = p.in[17] + l * 256;
            L.sta = p.in[3] + (size_t)l * 32 * 2 * 256; L.stb = p.in[4] + (size_t)l * 32 * 30 * 256; L.stp = p.in[5] + (size_t)l * 32 * 15 * 256;
            L.out = p.out; L.l = l;
            const int nk = (5 * NTILE - bx + G - 1) / G;
            for (int kk = 0; kk < nk; ++kk) {
                int k2 = kk + (bx >> 3) % nk; if (k2 >= nk) k2 -= nk;
                const int idx = bx + k2 * G;
                const int grp = idx / NTILE; const Tile T = mk_tile(idx % NTILE); const int hp = grp - 2;
                if (grp == 0) mix_b(L, T, tid, lds);
                else if (grp == 1) mix_c(L, T, tid, lds);
                else if (grp < 4) mix_x(L, T, hp, tid, lds);
                else mix_a(L, T, tid);
            }
        }
        xcd_barrier(bar);
        {
            PHASE_WS
            pg8::Gemm g{YB, WOUT + (size_t)l * D * D, M, D, D}; pg8::StaticOrder S; S.init(M, D, G, bx);
            EpiX E{XB, l == 0 ? SSPB : SSPA, XB};
            pg8::gemm_phase<EpiX, pg8::StaticOrder, true, true>(lds, g, S, E);
        }
        xcd_barrier(bar);
    }
    {
        PHASE_WS
        const int gw = bx * 8 + wave, NGW = G * 8;
        const float* gf = p.in[22];
        f32x4 gv[4];
#pragma unroll
        for (int j = 0; j < 4; ++j) gv[j] = ((const f32x4*)gf)[lane + 64 * j];
        for (int m = gw; m < M; m += NGW) {
            const f32x4* sp = (const f32x4*)(SSPA + (size_t)m * 16);
            const f32x4 s0 = sp[0], s1 = sp[1], s2 = sp[2], s3 = sp[3];
            const float ss = ((s0.x + s0.y) + (s0.z + s0.w)) + ((s1.x + s1.y) + (s1.z + s1.w)) + ((s2.x + s2.y) + (s2.z + s2.w)) + ((s3.x + s3.y) + (s3.z + s3.w));
            const float rstd = rsqrtf(ss * (1.f / 1024.f) + EPS);
            const v2u* xr = (const v2u*)(XB + (size_t)m * D) + lane;
            f32x4* yr = (f32x4*)(p.out + (size_t)m * D) + lane;
            v2u xv[4];
#pragma unroll
            for (int j = 0; j < 4; ++j) xv[j] = __builtin_nontemporal_load(xr + 64 * j);
#pragma unroll
            for (int j = 0; j < 4; ++j) { const f32x4 v = (f32x4){bflo(xv[j].x), bfhi(xv[j].x), bflo(xv[j].y), bfhi(xv[j].y)}; __builtin_nontemporal_store(v * rstd * gv[j], yr + 64 * j); }
        }
    }
}

extern "C" void kernel_launch(void* const* d_in, const int* in_sizes, int n_in, void* d_out, int out_size, void* d_ws, size_t ws_size, hipStream_t stream) {
    static int grid_blocks = 0;
    if (grid_blocks == 0) {
        if (n_in != 23 || (size_t)out_size != O_END || ws_size < WS_END) { fprintf(stderr, "kernel_launch: unexpected shapes (n_in %d out %d ws %zu)\n", n_in, out_size, ws_size); grid_blocks = -1; return; }
        int dev = 0, cus = 0, per_cu = 0;
        hipGetDevice(&dev);
        hipDeviceGetAttribute(&cus, hipDeviceAttributeMultiprocessorCount, dev);
        if (hipFuncSetAttribute((const void*)hymba_fwd, hipFuncAttributeMaxDynamicSharedMemorySize, LDS_BYTES) != hipSuccess) { fprintf(stderr, "kernel_launch: hipFuncSetAttribute failed\n"); grid_blocks = -1; return; }
        if (hipOccupancyMaxActiveBlocksPerMultiprocessor(&per_cu, (const void*)hymba_fwd, 512, LDS_BYTES) != hipSuccess || per_cu < 1) { fprintf(stderr, "kernel_launch: occupancy query says %d\n", per_cu); per_cu = 1; }
        (void)hipGetLastError();
        grid_blocks = cus * 1;
    }
    if (grid_blocks < 0) return;
    Params p{};
    for (int i = 0; i < 23; ++i) p.in[i] = (const float*)d_in[i];
    p.out = (float*)d_out; p.ws = (unsigned char*)d_ws;
    void* args[] = {&p};
    hipError_t e = hipLaunchCooperativeKernel((const void*)hymba_fwd, dim3(grid_blocks), dim3(512), args, LDS_BYTES, stream);
    if (e != hipSuccess) fprintf(stderr, "cooperative launch failed: %s (grid %d)\n", hipGetErrorString(e), grid_blocks);
}
```
